# Optimizing an MI355X kernel written in HIP

```python
import jax, jax.numpy as jnp
from jax import lax
import numpy as np

D_MODEL = 1024
BATCH = 16
SEQ = 2048
DEPTH = 2

CONV_WIDTH = D_MODEL // 2
CONV_KSIZE = 31
RWKV_WIDTH = D_MODEL // 2
RWKV_HEAD = 64
RWKV_HEADS = RWKV_WIDTH // RWKV_HEAD
W_LORA = 64
A_LORA = 32
RWKV_IN = 3 * RWKV_WIDTH + 2 * (W_LORA + A_LORA)
EVEN_COLS = 3 * CONV_WIDTH + RWKV_IN + RWKV_WIDTH
GLA_HEADS = 4
GLA_DK = D_MODEL // 2
GLA_DV = D_MODEL
GLA_HK = GLA_DK // GLA_HEADS
GLA_HV = GLA_DV // GLA_HEADS
GLA_RANK = 16
GLA_TAU = 16.0
GLA_CHUNK = 64
ODD_COLS = 2 * GLA_DK + 2 * GLA_DV + 2 * GLA_RANK
DEEPNORM_ALPHA = (2 * DEPTH) ** 0.25
DEEPNORM_BETA = (8 * DEPTH) ** -0.25
LN_EPS = 1e-5
RWKV_GN_EPS = 64e-5
RMS_EPS = 1e-6

kernel_name = "hybrid_conv_rwkv7_gla_deepnorm_encoder"


def _layernorm(x, g, b, eps):
    xf = x.astype(jnp.float32)
    mu = jnp.mean(xf, -1, keepdims=True)
    var = jnp.mean(jnp.square(xf - mu), -1, keepdims=True)
    return ((xf - mu) * lax.rsqrt(var + eps) * g + b).astype(x.dtype)


def _token_shift(z, mu):
    prev = jnp.pad(z[:, :-1], ((0, 0), (1, 0), (0, 0)))
    nxt = jnp.pad(z[:, 1:], ((0, 0), (0, 1), (0, 0)))
    return z + mu * (0.5 * (prev + nxt) - z)


def _conformer_conv(val, glu_gate, conv_w, conv_b, ln_g, ln_b):
    u = val * jax.nn.sigmoid(glu_gate)
    u = lax.conv_general_dilated(
        u, conv_w[:, None, :], window_strides=(1,),
        padding=((CONV_KSIZE // 2, CONV_KSIZE // 2),),
        dimension_numbers=('NWC', 'WIO', 'NWC'),
        feature_group_count=CONV_WIDTH) + conv_b
    u = _layernorm(u, ln_g, ln_b, LN_EPS)
    return jax.nn.silu(u)


def _heads(t, n_heads):
    return t.reshape(t.shape[:-1] + (n_heads, t.shape[-1] // n_heads))


def _rwkv7_bidir(z, mu_shift, w0, w_up, a0, a_up, k_k, k_a, r_k, gn_g, gn_b):
    Bn, T, _ = z.shape
    f32 = jnp.float32
    z = _token_shift(z, mu_shift)
    r, k, v, lora = jnp.split(z, [RWKV_WIDTH, 2 * RWKV_WIDTH, 3 * RWKV_WIDTH], axis=-1)
    lora = lora.reshape(Bn, T, 2, W_LORA + A_LORA)
    wl, al = lora[..., :W_LORA], lora[..., W_LORA:]
    w_pre = (w0 + jnp.einsum('btdr,drc->btdc', jnp.tanh(wl), w_up)).astype(f32)
    log_w = -jnp.exp(-jax.nn.softplus(-w_pre) - 0.5)
    a = jax.nn.sigmoid((a0 + jnp.einsum('btdr,drc->btdc', al, a_up)).astype(f32))
    rf, kf, vf = r.astype(f32), k.astype(f32), v.astype(f32)
    kk = _heads(kf * k_k.astype(f32), RWKV_HEADS)
    kk = kk * lax.rsqrt(jnp.sum(kk * kk, -1, keepdims=True) + 1e-12)
    k_mod = kf[:, :, None] * (1.0 + (a - 1.0) * k_a.astype(f32))
    rh, vh = _heads(rf, RWKV_HEADS), _heads(vf, RWKV_HEADS)
    kmh = _heads(k_mod, RWKV_HEADS)
    wh = _heads(jnp.exp(log_w), RWKV_HEADS)
    ah = _heads(a, RWKV_HEADS)

    def shared(t):
        return jnp.moveaxis(jnp.stack([t, t[:, ::-1]], 0), 2, 0)

    def per_dir(t):
        return jnp.moveaxis(jnp.stack([t[:, :, 0], t[:, ::-1, 1]], 0), 2, 0)

    def step(S, inp):
        r_t, w_t, k_t, v_t, kk_t, a_t = inp
        sa = jnp.einsum('dbhvk,dbhk->dbhv', S, -kk_t)
        S = (S * w_t[..., None, :] + sa[..., :, None] * (kk_t * a_t)[..., None, :]
             + v_t[..., :, None] * k_t[..., None, :])
        return S, jnp.einsum('dbhvk,dbhk->dbhv', S, r_t)

    S0 = jnp.zeros((2, Bn, RWKV_HEADS, RWKV_HEAD, RWKV_HEAD), f32)
    _, ys = lax.scan(step, S0, (shared(rh), per_dir(wh), per_dir(kmh), shared(vh),
                                 shared(kk), per_dir(ah)))
    ys = jnp.moveaxis(ys, 0, 2)
    y = ys[0] + ys[1][:, ::-1]
    mu = jnp.mean(y, -1, keepdims=True)
    var = jnp.mean(jnp.square(y - mu), -1, keepdims=True)
    y = ((y - mu) * lax.rsqrt(var + RWKV_GN_EPS)).reshape(Bn, T, RWKV_WIDTH) * gn_g + gn_b
    k_bonus = jnp.mean(kmh, axis=2)
    bonus = jnp.sum(rh * k_bonus * r_k.astype(f32), -1, keepdims=True) * vh
    return (y + bonus.reshape(Bn, T, RWKV_WIDTH)).astype(z.dtype)


def _even_mixer(x, w_in, conv_w, conv_b, conv_ln_g, conv_ln_b, mu_shift, w0, w_up, a0, a_up,
                k_k, k_a, r_k, gn_g, gn_b, w_out):
    proj = jnp.einsum('btd,de->bte', x, w_in)
    c_val, c_glu, gate_a, rwkv_in, gate_b = jnp.split(
        proj, [CONV_WIDTH, 2 * CONV_WIDTH, 3 * CONV_WIDTH, 3 * CONV_WIDTH + RWKV_IN], axis=-1)
    y_a = _conformer_conv(c_val, c_glu, conv_w, conv_b, conv_ln_g, conv_ln_b) * jax.nn.silu(gate_a)
    y_b = _rwkv7_bidir(rwkv_in, mu_shift, w0, w_up, a0, a_up, k_k, k_a, r_k, gn_g, gn_b) * jax.nn.silu(gate_b)
    return jnp.einsum('btc,cd->btd', jnp.concatenate([y_a, y_b], -1), w_out)


def _gla_chunked(q, k, v, log_a):
    Bn, H, T, dk = q.shape
    dv = v.shape[-1]
    nC = T // GLA_CHUNK
    q = q.reshape(Bn, H, nC, GLA_CHUNK, dk)
    k = k.reshape(Bn, H, nC, GLA_CHUNK, dk)
    v = v.reshape(Bn, H, nC, GLA_CHUNK, dv)
    b = jnp.cumsum(log_a.reshape(Bn, H, nC, GLA_CHUNK, dk), axis=-2)
    b_last = b[..., -1:, :]
    q_t = q * jnp.exp(b)
    k_t = k * jnp.exp(-b)
    mask = jnp.tril(jnp.ones((GLA_CHUNK, GLA_CHUNK), bool))
    scores = jnp.where(mask, jnp.einsum('bhnik,bhnjk->bhnij', q_t, k_t), 0.0)
    o_intra = jnp.einsum('bhnij,bhnjv->bhniv', scores, v)
    U = jnp.einsum('bhnjk,bhnjv->bhnkv', k * jnp.exp(b_last - b), v)
    decay = jnp.exp(b_last[..., 0, :])

    def step(S, inp):
        d_c, u_c = inp
        return d_c[..., None] * S + u_c, S

    S0 = jnp.zeros((Bn, H, dk, dv), q.dtype)
    _, S_prev = lax.scan(step, S0, (jnp.moveaxis(decay, 2, 0), jnp.moveaxis(U, 2, 0)))
    S_prev = jnp.moveaxis(S_prev, 0, 2)
    o_inter = jnp.einsum('bhnik,bhnkv->bhniv', q_t, S_prev)
    return (o_intra + o_inter).reshape(Bn, H, T, dv)


def _odd_mixer(x, w_in, g_up, g_bias, norm_g, w_out):
    Bn, T, _ = x.shape
    f32 = jnp.float32
    proj = jnp.einsum('btd,de->bte', x, w_in)
    q, k, v, gate, lr = jnp.split(
        proj, [GLA_DK, 2 * GLA_DK, 2 * GLA_DK + GLA_DV, 2 * GLA_DK + 2 * GLA_DV], axis=-1)
    lr = lr.reshape(Bn, T, 2, GLA_RANK)
    log_a = jax.nn.log_sigmoid(
        (jnp.einsum('btdr,drc->btdc', lr, g_up) + g_bias).astype(f32)) / GLA_TAU

    def hd(t):
        return t.astype(f32).reshape(Bn, T, GLA_HEADS, -1).transpose(0, 2, 1, 3)

    qh, kh, vh = hd(q) * (GLA_HK ** -0.5), hd(k), hd(v)
    la_f, la_b = hd(log_a[:, :, 0]), hd(log_a[:, :, 1])
    o_f = _gla_chunked(qh, kh, vh, la_f)
    o_b = _gla_chunked(qh[:, :, ::-1], kh[:, :, ::-1], vh[:, :, ::-1], la_b[:, :, ::-1])[:, :, ::-1]
    o = o_f + o_b
    o = o * lax.rsqrt(jnp.mean(o * o, -1, keepdims=True) + RMS_EPS)
    o = o.transpose(0, 2, 1, 3).reshape(Bn, T, GLA_DV) * norm_g
    o = o.astype(x.dtype) * jax.nn.silu(gate)
    return jnp.einsum('btc,cd->btd', o, w_out)


def setup_inputs(seed: int = 0) -> dict:
    key = jax.random.key(seed)
    ks = jax.random.split(key, 32)

    def nrm(i, shape, s):
        return jax.random.normal(ks[i], shape, jnp.float32) * s

    return {
        "x": nrm(0, (BATCH, SEQ, D_MODEL), 1.0),
        "l0_w_in": nrm(1, (D_MODEL, EVEN_COLS), D_MODEL ** -0.5),
        "l0_conv_w": nrm(2, (CONV_KSIZE, CONV_WIDTH), CONV_KSIZE ** -0.5),
        "l0_conv_b": nrm(3, (CONV_WIDTH,), 0.01),
        "l0_conv_ln_g": 1.0 + nrm(4, (CONV_WIDTH,), 0.02),
        "l0_conv_ln_b": nrm(5, (CONV_WIDTH,), 0.02),
        "l0_mu_shift": jax.random.uniform(ks[6], (RWKV_IN,), jnp.float32, 0.2, 0.8),
        "l0_w0": jax.random.uniform(ks[7], (2, RWKV_WIDTH), jnp.float32, -5.0, -1.0),
        "l0_w_up": nrm(8, (2, W_LORA, RWKV_WIDTH), 0.1),
        "l0_a0": nrm(9, (2, RWKV_WIDTH), 0.1),
        "l0_a_up": nrm(10, (2, A_LORA, RWKV_WIDTH), 0.5 * A_LORA ** -0.5),
        "l0_k_k": 0.85 + nrm(11, (RWKV_WIDTH,), 0.02),
        "l0_k_a": 1.0 + nrm(12, (RWKV_WIDTH,), 0.02),
        "l0_r_k": nrm(13, (RWKV_HEADS, RWKV_HEAD), 0.1),
        "l0_gn_g": 1.0 + nrm(14, (RWKV_WIDTH,), 0.02),
        "l0_gn_b": nrm(15, (RWKV_WIDTH,), 0.02),
        "l0_w_out": nrm(16, (CONV_WIDTH + RWKV_WIDTH, D_MODEL), DEEPNORM_BETA * (CONV_WIDTH + RWKV_WIDTH) ** -0.5),
        "l0_ln_g": 1.0 + nrm(17, (D_MODEL,), 0.02),
        "l0_ln_b": nrm(18, (D_MODEL,), 0.02),
        "l1_w_in": nrm(19, (D_MODEL, ODD_COLS), D_MODEL ** -0.5),
        "l1_g_up": nrm(20, (2, GLA_RANK, GLA_DK), 0.5 * GLA_RANK ** -0.5),
        "l1_g_bias": nrm(21, (2, GLA_DK), 0.1),
        "l1_norm_g": 1.0 + nrm(22, (GLA_DV,), 0.02),
        "l1_w_out": nrm(23, (GLA_DV, D_MODEL), DEEPNORM_BETA * GLA_DV ** -0.5),
        "l1_ln_g": 1.0 + nrm(24, (D_MODEL,), 0.02),
        "l1_ln_b": nrm(25, (D_MODEL,), 0.02),
    }


def reference(x, l0_w_in, l0_conv_w, l0_conv_b, l0_conv_ln_g, l0_conv_ln_b, l0_mu_shift,
              l0_w0, l0_w_up, l0_a0, l0_a_up, l0_k_k, l0_k_a, l0_r_k, l0_gn_g, l0_gn_b,
              l0_w_out, l0_ln_g, l0_ln_b, l1_w_in, l1_g_up, l1_g_bias, l1_norm_g, l1_w_out,
              l1_ln_g, l1_ln_b):
    even = (l0_w_in, l0_conv_w, l0_conv_b, l0_conv_ln_g, l0_conv_ln_b, l0_mu_shift, l0_w0,
            l0_w_up, l0_a0, l0_a_up, l0_k_k, l0_k_a, l0_r_k, l0_gn_g, l0_gn_b, l0_w_out)
    odd = (l1_w_in, l1_g_up, l1_g_bias, l1_norm_g, l1_w_out)
    norms = ((l0_ln_g, l0_ln_b), (l1_ln_g, l1_ln_b))
    for i in range(DEPTH):
        if i % 2 == 0:
            h = _even_mixer(x, *even)
        else:
            h = _odd_mixer(x, *odd)
        g, b = norms[i]
        x = _layernorm(DEEPNORM_ALPHA * x + h, g, b, LN_EPS)
    return x
```

```cpp
#include <hip/hip_runtime.h>
#include <hip/hip_cooperative_groups.h>
#include <cstdio>
namespace cg = cooperative_groups;

typedef unsigned short bf16_t;
typedef short bf16x8 __attribute__((ext_vector_type(8)));
typedef float f32x4 __attribute__((ext_vector_type(4)));
typedef float f32x2 __attribute__((ext_vector_type(2)));

#define T_ 2048
#define NB_ 16
#define NTOK 32768
#define DM 1024
#define N0 3776
#define N0P 3840
#define N1 3104
#define N1P 3328
#define ALPHA 1.41421356237f
#define NTHR 512
#define LDS_BYTES 139264

#define MAXPH 1
#define DUMPMODE 1

struct Params {
  const float* x; const float* w_in0; const float* conv_w; const float* conv_b; const float* conv_ln_g; const float* conv_ln_b;
  const float* mu; const float* w0; const float* w_up; const float* a0; const float* a_up; const float* k_k; const float* k_a; const float* r_k;
  const float* gn_g; const float* gn_b; const float* w_out0; const float* ln0_g; const float* ln0_b;
  const float* w_in1; const float* g_up; const float* g_bias; const float* norm_g; const float* w_out1; const float* ln1_g; const float* ln1_b;
  float* out;
  bf16_t* xb; bf16_t* ys; bf16_t* go; bf16_t* hb;
  bf16_t* wt0; bf16_t* wto0; bf16_t* wt1; bf16_t* wto1;
  bf16_t* proj; bf16_t* ycat; float* beta; bf16_t* x1k; unsigned* bar;
  int ph_lo; int ph_hi;
};

typedef __bf16 bf16x2_t __attribute__((ext_vector_type(2)));
__device__ __forceinline__ unsigned pk_bf16(float lo, float hi) {
  const f32x2 v = (f32x2){lo, hi};
  const bf16x2_t b = __builtin_convertvector(v, bf16x2_t);
  return __builtin_bit_cast(unsigned, b);
}
__device__ __forceinline__ bf16_t f2bf(float v) { return (bf16_t)(pk_bf16(v, 0.f) & 0xffffu); }
__device__ __forceinline__ float bf2f(bf16_t v) { return __uint_as_float(((unsigned)v) << 16); }
__device__ __forceinline__ float sigmoidf_(float x) { return __builtin_amdgcn_rcpf(1.f + __expf(-x)); }
__device__ __forceinline__ float siluf_(float x) { return x * __builtin_amdgcn_rcpf(1.f + __expf(-x)); }
__device__ __forceinline__ float tanhf_(float x) { return 1.f - 2.f * __builtin_amdgcn_rcpf(1.f + __expf(2.f * x)); }
template <int CTRL> __device__ __forceinline__ float dppf0(float x) {
  return __int_as_float(__builtin_amdgcn_update_dpp(0, __float_as_int(x), CTRL, 0xF, 0xF, true));
}
__device__ __forceinline__ float wave_sum(float v) {
  v += dppf0<0xB1>(v); v += dppf0<0x4E>(v); v += dppf0<0x141>(v); v += dppf0<0x140>(v);
  const int vi = __float_as_int(v);
  const float r0 = __int_as_float(__builtin_amdgcn_readlane(vi, 0)), r1 = __int_as_float(__builtin_amdgcn_readlane(vi, 16));
  const float r2 = __int_as_float(__builtin_amdgcn_readlane(vi, 32)), r3 = __int_as_float(__builtin_amdgcn_readlane(vi, 48));
  return (r0 + r1) + (r2 + r3);
}
template <int CTRL> __device__ __forceinline__ float dppf(float x) {
  return __int_as_float(__builtin_amdgcn_update_dpp(0, __float_as_int(x), CTRL, 0xF, 0xF, true));
}

__device__ __forceinline__ void wtrans_tile(const float* __restrict__ W, int N, bf16_t* __restrict__ Wt, int kt, int nt, float* tile) {
  const int tid = threadIdx.x;
  const int k0 = kt * 64, n0 = nt * 64;
  {
    const int r = tid >> 4, c4 = (tid & 15) * 4;
#pragma unroll
    for (int hh = 0; hh < 2; ++hh) {
      const int rr = r + hh * 32;
      float4 v = make_float4(0.f, 0.f, 0.f, 0.f);
      if (n0 + c4 < N) v = *(const float4*)(W + (size_t)(k0 + rr) * N + n0 + c4);
      tile[rr * 65 + c4 + 0] = v.x; tile[rr * 65 + c4 + 1] = v.y; tile[rr * 65 + c4 + 2] = v.z; tile[rr * 65 + c4 + 3] = v.w;
    }
  }
  __syncthreads();
  {
    const int n = tid >> 3, k8 = (tid & 7) * 8;
    float v[8];
#pragma unroll
    for (int i = 0; i < 8; ++i) v[i] = tile[(k8 + i) * 65 + n];
    uint4 o; o.x = pk_bf16(v[0], v[1]); o.y = pk_bf16(v[2], v[3]); o.z = pk_bf16(v[4], v[5]); o.w = pk_bf16(v[6], v[7]);
    *(uint4*)(Wt + (size_t)(n0 + n) * DM + k0 + k8) = o;
  }
  __syncthreads();
}

__device__ __forceinline__ void phase_prep(const Params& p, char* smem) {
  const size_t n8 = (size_t)NTOK * DM / 8;
  for (size_t i = (size_t)blockIdx.x * NTHR + threadIdx.x; i < n8; i += (size_t)gridDim.x * NTHR) {
    const float4* src = (const float4*)(p.x) + i * 2;
    float4 a = src[0], b = src[1];
    uint4 o; o.x = pk_bf16(a.x, a.y); o.y = pk_bf16(a.z, a.w); o.z = pk_bf16(b.x, b.y); o.w = pk_bf16(b.z, b.w);
    ((uint4*)p.xb)[i] = o;
  }
  float* tile = (float*)smem;
  for (int u = blockIdx.x; u < 2304; u += gridDim.x) {
    if (u < 960) wtrans_tile(p.w_in0, N0, p.wt0, u / 60, u % 60, tile);
    else if (u < 1216) { int v = u - 960; wtrans_tile(p.w_out0, DM, p.wto0, v / 16, v % 16, tile); }
    else if (u < 2048) { int v = u - 1216; wtrans_tile(p.w_in1, N1, p.wt1, v / 52, v % 52, tile); }
    else { int v = u - 2048; wtrans_tile(p.w_out1, DM, p.wto1, v / 16, v % 16, tile); }
  }
}

namespace pg8 {
#define PG8_LAS __attribute__((address_space(3)))
constexpr int BM = 256, BK = 64, HALF = 128, HTB = HALF * BK * 2, NXCD = 8, WGM = 8;
__device__ __forceinline__ int lds_byte(int r, int c) { const int st = (r >> 4) * 2 + (c >> 5), rr = r & 15, cc = c & 31, ob = rr * 64 + cc * 2; return st * 1024 + (ob ^ (((ob >> 9) & 1) << 5)); }
__device__ __forceinline__ void stage_rc(int b, int& R, int& C) { const int st = b / 1024, sb = b % 1024, swz = sb ^ (((sb >> 9) & 1) << 5); R = (st >> 1) * 16 + swz / 64; C = (st & 1) * 32 + (swz % 64) / 2; }
__device__ __forceinline__ int perm32(int rho) { const int n = rho >> 4, i = rho & 15; return 8 * (i >> 2) + 4 * n + (i & 3); }
struct Unit { int pm, pn; };
struct Gemm { const bf16_t* A; const bf16_t* Bt; int M, N, K; };
struct StaticOrder {
  int nM, nN, nwg, G, c;
  __device__ void init(int M, int N, int G_, int c_) { nM = M / BM; nN = N / BM; nwg = nM * nN; G = G_; c = c_; }
  __device__ bool next(int i, Unit& u) const {
    const long L = (long)i * G + c; if (L >= nwg) return false;
    int wgid = (int)L; { const int q = nwg / NXCD, r = nwg % NXCD, xcd = wgid % NXCD, off = wgid / NXCD; wgid = (xcd < r ? xcd * (q + 1) : r * (q + 1) + (xcd - r) * q) + off; }
    const int nig = WGM * nN, gid = wgid / nig, fm = gid * WGM, gsz = (nM - fm) < WGM ? (nM - fm) : WGM;
    u.pm = fm + ((wgid % nig) % gsz); u.pn = (wgid % nig) / gsz; return true;
  }
};
struct EpiBf16 {
  static constexpr bool PERM = true;
  bf16_t* O; int ldc;
  __device__ __forceinline__ void operator()(const f32x4 (&acc)[2][2][4][2], const Unit& u, int wr, int wc, int fr, int fq) const {
    const int row0 = u.pm * BM + wr * 64 + fr, col0 = u.pn * BM + wc * 32 + 8 * fq;
#pragma unroll
    for (int ai = 0; ai < 2; ++ai)
#pragma unroll
      for (int m = 0; m < 4; ++m) {
        bf16_t* rowp = O + (size_t)(row0 + ai * HALF + m * 16) * ldc + col0;
#pragma unroll
        for (int bj = 0; bj < 2; ++bj) {
          const f32x4 v0 = acc[ai][bj][m][0], v1 = acc[ai][bj][m][1];
          uint4 o; o.x = pk_bf16(v0[0], v0[1]); o.y = pk_bf16(v0[2], v0[3]); o.z = pk_bf16(v1[0], v1[1]); o.w = pk_bf16(v1[2], v1[3]);
          *(uint4*)(rowp + bj * HALF) = o;
        }
      }
  }
};
struct EpiRes {
  static constexpr bool PERM = false;
  const float* X; float* Y;
  __device__ __forceinline__ void operator()(const f32x4 (&acc)[2][2][4][2], const Unit& u, int wr, int wc, int fr, int fq) const {
    const int row0 = u.pm * BM + wr * 64 + fr, col0 = u.pn * BM + wc * 32 + 4 * fq;
#pragma unroll
    for (int ai = 0; ai < 2; ++ai)
#pragma unroll
      for (int m = 0; m < 4; ++m) {
        const size_t ro = (size_t)(row0 + ai * HALF + m * 16) * DM + col0;
#pragma unroll
        for (int bj = 0; bj < 2; ++bj)
#pragma unroll
          for (int n = 0; n < 2; ++n) {
            const f32x4 xr = *(const f32x4*)(X + ro + bj * HALF + n * 16);
            *(f32x4*)(Y + ro + bj * HALF + n * 16) = xr * ALPHA + acc[ai][bj][m][n];
          }
      }
  }
};

template <class Epi>
__device__ __forceinline__ void gemm_phase(PG8_LAS unsigned char* lds, const Gemm g, const StaticOrder& S, const Epi& E) {
  const int tid = threadIdx.x, wid = __builtin_amdgcn_readfirstlane(tid >> 6), lane = tid & 63, wr = wid >> 2, wc = wid & 3, fr = lane & 15, fq = lane >> 4;
  const int K = g.K, nt = K / BK;
  unsigned voffA[2], voffB[2];
#pragma unroll
  for (int i = 0; i < 2; ++i) { int R, C; stage_rc(tid * 16 + i * 8192, R, C); const int Rb = Epi::PERM ? ((R & ~31) + perm32(R & 31)) : R;
    voffA[i] = (unsigned)(R * K + C) * 2u; voffB[i] = (unsigned)(Rb * K + C) * 2u; }
  const size_t kstep = (size_t)(BK * 2);
  const size_t hstep = (size_t)HALF * K * 2;
  const size_t tstep = 2 * hstep;
  const unsigned ldsw = (unsigned)wid * 1024u;
  const int aoff = lds_byte(wr * 64 + fr, fq * 8), boff = lds_byte(wc * 32 + fr, fq * 8);
#define PG8_SA(b, h) (((b) * 2 + (h)) * HTB)
#define PG8_SB(b, h) ((4 + (b) * 2 + (h)) * HTB)
#define PG8_STAGE(bufoff, gbase, voff) do { _Pragma("unroll") for (int _i = 0; _i < 2; ++_i) \
    __builtin_amdgcn_global_load_lds((const unsigned*)((const char*)(gbase) + (voff)[_i]), (PG8_LAS unsigned*)(lds + (bufoff) + ldsw + _i * 8192), 16, 0, 0); } while (0)
#define PG8_LDA(dst, b, h) do { _Pragma("unroll") for (int m = 0; m < 4; ++m) _Pragma("unroll") for (int k = 0; k < 2; ++k) dst[m][k] = *(const PG8_LAS bf16x8*)(lds + PG8_SA(b, h) + aoff + m * 2048 + k * 1024); } while (0)
#define PG8_LDB(dst, b, h) do { _Pragma("unroll") for (int n = 0; n < 2; ++n) _Pragma("unroll") for (int k = 0; k < 2; ++k) dst[n][k] = *(const PG8_LAS bf16x8*)(lds + PG8_SB(b, h) + boff + n * 2048 + k * 1024); } while (0)
#define PG8_MMA(ai, bj, At, Bt) do { __builtin_amdgcn_s_setprio(1); _Pragma("unroll") for (int m = 0; m < 4; ++m) _Pragma("unroll") for (int n = 0; n < 2; ++n) _Pragma("unroll") for (int k = 0; k < 2; ++k) \
    acc[ai][bj][m][n] = __builtin_amdgcn_mfma_f32_16x16x32_bf16(Bt[n][k], At[m][k], acc[ai][bj][m][n], 0, 0, 0); __builtin_amdgcn_s_setprio(0); } while (0)
#define PG8_WAIT_V(n) asm volatile("s_waitcnt vmcnt(" #n ")" ::: "memory")
#define PG8_WAIT_L(n) asm volatile("s_waitcnt lgkmcnt(" #n ")" ::: "memory")
#define PG8_BAR __builtin_amdgcn_s_barrier()
#define PG8_SCHED __builtin_amdgcn_sched_barrier(0)
  Unit cur, nxt; int ui = 0;
  if (!S.next(0, cur)) return;
  f32x4 acc[2][2][4][2];
#pragma unroll
  for (int a = 0; a < 2; ++a)
#pragma unroll
    for (int b = 0; b < 2; ++b)
#pragma unroll
      for (int m = 0; m < 4; ++m)
#pragma unroll
        for (int n = 0; n < 2; ++n) acc[a][b][m][n] = (f32x4){0.f, 0.f, 0.f, 0.f};
  bf16x8 At[4][2], B0[2][2], B1[2][2];
  const char* cA = (const char*)g.A + (size_t)cur.pm * tstep; const char* cB = (const char*)g.Bt + (size_t)cur.pn * tstep;
  PG8_STAGE(PG8_SB(0, 0), cB, voffB); PG8_STAGE(PG8_SA(0, 0), cA, voffA); PG8_STAGE(PG8_SB(0, 1), cB + hstep, voffB); PG8_STAGE(PG8_SA(0, 1), cA + hstep, voffA);
  if (wr == 1) PG8_BAR;
  PG8_WAIT_V(4); PG8_BAR;
  PG8_STAGE(PG8_SB(1, 0), cB + kstep, voffB); PG8_STAGE(PG8_SA(1, 0), cA + kstep, voffA); PG8_STAGE(PG8_SB(1, 1), cB + hstep + kstep, voffB);
  PG8_WAIT_V(6); PG8_BAR;
  for (;;) {
    const bool has_next = S.next(ui + 1, nxt);
    const char* nA = has_next ? (const char*)g.A + (size_t)nxt.pm * tstep : cA; const char* nB = has_next ? (const char*)g.Bt + (size_t)nxt.pn * tstep : cB;
    for (int t = 0; t < nt; t += 2) {
      const bool last = (t == nt - 2);
      const char* a1 = cA + (size_t)(t + 1) * kstep;
      const char* a2 = last ? nA : cA + (size_t)(t + 2) * kstep; const char* b2 = last ? nB : cB + (size_t)(t + 2) * kstep;
      const char* a3 = a2 + kstep; const char* b3 = b2 + kstep;
      PG8_LDB(B0, 0, 0); PG8_SCHED; PG8_LDA(At, 0, 0); PG8_STAGE(PG8_SA(1, 1), a1 + hstep, voffA);
      PG8_WAIT_L(8); PG8_BAR; PG8_WAIT_L(0); PG8_MMA(0, 0, At, B0); PG8_BAR; PG8_SCHED;
      PG8_LDB(B1, 0, 1); PG8_STAGE(PG8_SB(0, 0), b2, voffB);
      PG8_BAR; PG8_WAIT_L(0); PG8_MMA(0, 1, At, B1); PG8_BAR;
      PG8_LDA(At, 0, 1); PG8_STAGE(PG8_SA(0, 0), a2, voffA);
      PG8_BAR; PG8_WAIT_L(0); PG8_MMA(1, 0, At, B0); PG8_BAR; PG8_SCHED;
      PG8_STAGE(PG8_SB(0, 1), b2 + hstep, voffB);
      PG8_WAIT_V(6); PG8_BAR; PG8_MMA(1, 1, At, B1); PG8_BAR;
      PG8_LDB(B0, 1, 0); PG8_SCHED; PG8_LDA(At, 1, 0); PG8_STAGE(PG8_SA(0, 1), a2 + hstep, voffA);
      PG8_WAIT_L(8); PG8_BAR; PG8_WAIT_L(0); PG8_MMA(0, 0, At, B0); PG8_BAR; PG8_SCHED;
      PG8_LDB(B1, 1, 1); PG8_STAGE(PG8_SB(1, 0), b3, voffB);
      PG8_BAR; PG8_WAIT_L(0); PG8_MMA(0, 1, At, B1); PG8_BAR;
      PG8_LDA(At, 1, 1); PG8_STAGE(PG8_SA(1, 0), a3, voffA);
      PG8_BAR; PG8_WAIT_L(0); PG8_MMA(1, 0, At, B0); PG8_BAR; PG8_SCHED;
      PG8_STAGE(PG8_SB(1, 1), b3 + hstep, voffB);
      PG8_WAIT_V(6); PG8_BAR; PG8_MMA(1, 1, At, B1); PG8_BAR;
    }
    E(acc, cur, wr, wc, fr, fq);
    if (!has_next) break;
#pragma unroll
    for (int a = 0; a < 2; ++a)
#pragma unroll
      for (int b = 0; b < 2; ++b)
#pragma unroll
        for (int m = 0; m < 4; ++m)
#pragma unroll
          for (int n = 0; n < 2; ++n) acc[a][b][m][n] = (f32x4){0.f, 0.f, 0.f, 0.f};
    cur = nxt; cA = nA; cB = nB; ++ui;
  }
  PG8_WAIT_V(0);
  if (wr == 0) PG8_BAR;
  PG8_BAR;
#undef PG8_SA
#undef PG8_SB
#undef PG8_STAGE
#undef PG8_LDA
#undef PG8_LDB
#undef PG8_MMA
#undef PG8_WAIT_V
#undef PG8_WAIT_L
#undef PG8_BAR
#undef PG8_SCHED
}
}

template <class Epi>
__device__ __forceinline__ void gemm_run(const bf16_t* A, const bf16_t* Bt, int N, const Epi& E, char* smem) {
  pg8::Gemm g; g.A = A; g.Bt = Bt; g.M = NTOK; g.N = N; g.K = DM;
  pg8::StaticOrder S; S.init(NTOK, N, (int)gridDim.x, (int)blockIdx.x);
  pg8::gemm_phase<Epi>((PG8_LAS unsigned char*)smem, g, S, E);
  __syncthreads();
}

__device__ __forceinline__ void phase_conv(const Params& p, char* smem) {
  float* u = (float*)smem;
  const int tid = threadIdx.x, lane = tid & 63, wid = tid >> 6;
  const int c = tid;
  float w[31];
#pragma unroll
  for (int j = 0; j < 31; ++j) w[j] = p.conv_w[j * 512 + c];
  const float bias = p.conv_b[c];
  const int c8 = lane * 8;
  for (int tile = blockIdx.x; tile < 1024; tile += gridDim.x) {
    const int b = tile >> 6, t0 = (tile & 63) * 32;
#pragma unroll
    for (int it = 0; it < 8; ++it) {
      const int tt = wid + 8 * it;
      if (tt < 62) {
        const int t = t0 - 15 + tt;
        f32x4 u0 = (f32x4){0.f, 0.f, 0.f, 0.f}, u1 = (f32x4){0.f, 0.f, 0.f, 0.f};
        if (t >= 0 && t < T_) {
          const bf16_t* row = p.proj + (size_t)(b * T_ + t) * N0P;
          const uint4 v4 = *(const uint4*)(row + c8), g4 = *(const uint4*)(row + 512 + c8);
          const unsigned vw[4] = {v4.x, v4.y, v4.z, v4.w}, gw[4] = {g4.x, g4.y, g4.z, g4.w};
          float uu[8];
#pragma unroll
          for (int j = 0; j < 4; ++j) {
            uu[2 * j] = __uint_as_float(vw[j] << 16) * sigmoidf_(__uint_as_float(gw[j] << 16));
            uu[2 * j + 1] = __uint_as_float(vw[j] & 0xffff0000u) * sigmoidf_(__uint_as_float(gw[j] & 0xffff0000u));
          }
          u0 = (f32x4){uu[0], uu[1], uu[2], uu[3]}; u1 = (f32x4){uu[4], uu[5], uu[6], uu[7]};
        }
        *(f32x4*)(u + tt * 512 + c8) = u0; *(f32x4*)(u + tt * 512 + c8 + 4) = u1;
      }
    }
    __syncthreads();
    {
      float uin[47];
#pragma unroll
      for (int hh = 0; hh < 2; ++hh) {
#pragma unroll
        for (int r = 0; r < 46; ++r) uin[r] = u[(hh * 16 + r) * 512 + c];
        float accs[16];
#pragma unroll
        for (int ti = 0; ti < 16; ++ti) {
          float acc = bias;
#pragma unroll
          for (int j = 0; j < 31; ++j) acc += w[j] * uin[ti + j];
          accs[ti] = acc;
        }
        __syncthreads();
#pragma unroll
        for (int ti = 0; ti < 16; ++ti) u[(hh * 16 + ti) * 512 + c] = accs[ti];
      }
    }
    __syncthreads();
#pragma unroll 2
    for (int ti = wid; ti < 32; ti += 8) {
      const size_t tok = (size_t)b * T_ + t0 + ti;
      const uint4 g4 = *(const uint4*)(p.proj + tok * N0P + 1024 + c8);
      const f32x4 a0 = *(const f32x4*)(u + ti * 512 + c8), a1 = *(const f32x4*)(u + ti * 512 + c8 + 4);
      float v[8] = {a0[0], a0[1], a0[2], a0[3], a1[0], a1[1], a1[2], a1[3]};
      float s = 0.f;
#pragma unroll
      for (int i = 0; i < 8; ++i) s += v[i];
      const float mean = wave_sum(s) * (1.f / 512.f);
      float q = 0.f;
#pragma unroll
      for (int i = 0; i < 8; ++i) { v[i] -= mean; q += v[i] * v[i]; }
      const float rstd = rsqrtf(wave_sum(q) * (1.f / 512.f) + 1e-5f);
      const f32x4 lg0 = *(const f32x4*)(p.conv_ln_g + c8), lg1 = *(const f32x4*)(p.conv_ln_g + c8 + 4);
      const f32x4 lb0 = *(const f32x4*)(p.conv_ln_b + c8), lb1 = *(const f32x4*)(p.conv_ln_b + c8 + 4);
      const unsigned gw[4] = {g4.x, g4.y, g4.z, g4.w};
      unsigned ow[4];
#pragma unroll
      for (int j = 0; j < 4; ++j) {
        const float lga = (j < 2) ? lg0[2 * j] : lg1[2 * j - 4], lgb = (j < 2) ? lg0[2 * j + 1] : lg1[2 * j - 3];
        const float lba = (j < 2) ? lb0[2 * j] : lb1[2 * j - 4], lbb = (j < 2) ? lb0[2 * j + 1] : lb1[2 * j - 3];
        float ya = siluf_(v[2 * j] * rstd * lga + lba), yb = siluf_(v[2 * j + 1] * rstd * lgb + lbb);
        ya *= siluf_(__uint_as_float(gw[j] << 16)); yb *= siluf_(__uint_as_float(gw[j] & 0xffff0000u));
        ow[j] = pk_bf16(ya, yb);
      }
      *(uint4*)(p.ycat + tok * DM + c8) = make_uint4(ow[0], ow[1], ow[2], ow[3]);
    }
    __syncthreads();
  }
}

__device__ __forceinline__ void phase_scan(const Params& p, char* smem) {
  bf16_t* WupT = (bf16_t*)smem;
  bf16_t* AupT = (bf16_t*)(smem + 9216);
  float* MU = (float*)(smem + 14336);
  bf16_t* SB = (bf16_t*)(smem + 15488);
  bf16_t* TW = (bf16_t*)(smem + 24704);
  bf16_t* AL = (bf16_t*)(smem + 29312);
  float* WP = (float*)(smem + 31872);
  float* AP = (float*)(smem + 40064);
  float* GT = (float*)(smem + 131200);
  float* GC = (float*)(smem + 133248);
  float* KKv = (float*)(smem + 48256); float* Bv = KKv + 2048; float* KMv = Bv + 2048; float* LWv = KMv + 2048;
  float* Rv = LWv + 2048; float* Vv = Rv + 2048;
  bf16_t* MAK = (bf16_t*)(smem + 48256);
  bf16_t* MRB = (bf16_t*)(smem + 50816);
  bf16_t* MRK = (bf16_t*)(smem + 53376);
  float* MAB = (float*)(smem + 55936);
  float* Wb = (float*)(smem + 60544);
  bf16_t* UT = (bf16_t*)(smem + 31872);
  bf16_t* RAW = (bf16_t*)(smem + 97408);
  bf16_t* AH = (bf16_t*)(smem + 97408);
  bf16_t* BH = (bf16_t*)(smem + 102016);
  bf16_t* KH = (bf16_t*)(smem + 106624);
  bf16_t* RH = (bf16_t*)(smem + 111232);
  bf16_t* BTT = (bf16_t*)(smem + 115840);
  bf16_t* KTT = (bf16_t*)(smem + 120960);
  bf16_t* VT = (bf16_t*)(smem + 126080);
  const int tid = threadIdx.x, lane = tid & 63, wid = tid >> 6;
  const int fr = lane & 15, fq = lane >> 4;
  for (int seq = blockIdx.x; seq < 256; seq += gridDim.x) {
    const int d = seq >> 7, b = (seq >> 3) & 15, h = seq & 7;
    __syncthreads();
    if (tid < 288) MU[tid] = (tid < 192) ? p.mu[(tid >> 6) * 512 + h * 64 + (tid & 63)] : p.mu[1536 + d * 96 + (tid - 192)];
#pragma unroll
    for (int i = 0; i < 8; ++i) { const int e = tid + 512 * i; const int j = e >> 6, c = e & 63; WupT[c * 72 + j] = f2bf(p.w_up[((size_t)d * 64 + j) * 512 + h * 64 + c]); }
#pragma unroll
    for (int i = 0; i < 4; ++i) { const int e = tid + 512 * i; const int j = e >> 6, c = e & 63; AupT[c * 40 + j] = f2bf(p.a_up[((size_t)d * 32 + j) * 512 + h * 64 + c]); }
    const int ptok = tid >> 4, pc4 = (tid & 15) * 4;
    float w0v[4], a0v[4], kkc[4], kac[4], rkc[4];
#pragma unroll
    for (int i = 0; i < 4; ++i) {
      const int ch = h * 64 + pc4 + i;
      w0v[i] = p.w0[d * 512 + ch]; a0v[i] = p.a0[d * 512 + ch]; kkc[i] = p.k_k[ch]; kac[i] = p.k_a[ch]; rkc[i] = p.r_k[ch];
    }
    f32x4 accS[2];
    accS[0] = (f32x4){0.f, 0.f, 0.f, 0.f}; accS[1] = (f32x4){0.f, 0.f, 0.f, 0.f};
    for (int i = tid; i < 64 * 72 / 2; i += NTHR) ((unsigned*)SB)[i] = 0u;
    const bf16_t* pbase = p.proj + (size_t)b * T_ * N0P;
    uint4 pc0, pp0, pn0, pc1, pp1, pn1, pc2, pp2, pn2;
#define SCAN_LD(PC, PP, PN, TOK, CK, CI) do { \
      const int s_ = (CI) * 32 + (TOK); const int t_ = d ? (T_ - 1 - s_) : s_; \
      const int col_ = ((CK) < 24) ? (1536 + ((CK) >> 3) * 512 + h * 64 + ((CK) & 7) * 8) : (3072 + d * 96 + ((CK) - 24) * 8); \
      const bf16_t* g_ = pbase + (size_t)t_ * N0P + col_; \
      PC = *(const uint4*)g_; PP = make_uint4(0u, 0u, 0u, 0u); PN = make_uint4(0u, 0u, 0u, 0u); \
      if (t_ > 0) PP = *(const uint4*)(g_ - N0P); \
      if (t_ < T_ - 1) PN = *(const uint4*)(g_ + N0P); } while (0)
#define SCAN_ITEMS(TID) \
      const int tokA = (TID) / 24, ckA = (TID) - tokA * 24; \
      const int tokB = ((TID) + 512) / 24, ckB = ((TID) + 512) - tokB * 24; \
      const int tokC = (wid < 4) ? ((TID) >> 3) : (((TID) - 256) >> 2), ckC = (wid < 4) ? (24 + ((TID) & 7)) : (32 + (((TID) - 256) & 3));
#define SCAN_LOAD_ALL(CI) do { \
      SCAN_LD(pc0, pp0, pn0, tokA, ckA, CI); \
      if (wid < 4) SCAN_LD(pc1, pp1, pn1, tokB, ckB, CI); \
      if (wid < 6) SCAN_LD(pc2, pp2, pn2, tokC, ckC, CI); } while (0)
    {
      SCAN_ITEMS((int)threadIdx.x)
      pc1 = pp1 = pn1 = pc2 = pp2 = pn2 = make_uint4(0u, 0u, 0u, 0u);
      SCAN_LOAD_ALL(0);
    }
    for (int ci = 0; ci < 64; ++ci) {
      int lz = 0; asm volatile("" : "+v"(lz));
      const int tid = (int)threadIdx.x + lz, lane = tid & 63, fr = lane & 15, fq = lane >> 4, ptok = tid >> 4, pc4 = (tid & 15) * 4;
      SCAN_ITEMS(tid)
#define SHIFT8(ZC, ZP, ZN, CK, VAL) do { \
        const f32x4 m0 = *(const f32x4*)(MU + (CK) * 8), m1 = *(const f32x4*)(MU + (CK) * 8 + 4); \
        const unsigned zcw[4] = {ZC.x, ZC.y, ZC.z, ZC.w}, zpw[4] = {ZP.x, ZP.y, ZP.z, ZP.w}, znw[4] = {ZN.x, ZN.y, ZN.z, ZN.w}; \
        _Pragma("unroll") for (int j = 0; j < 4; ++j) { \
          const float c0 = __uint_as_float(zcw[j] << 16), c1 = __uint_as_float(zcw[j] & 0xffff0000u); \
          const float p0 = __uint_as_float(zpw[j] << 16), p1 = __uint_as_float(zpw[j] & 0xffff0000u); \
          const float n0 = __uint_as_float(znw[j] << 16), n1 = __uint_as_float(znw[j] & 0xffff0000u); \
          const float mm0 = (j < 2) ? m0[2 * j] : m1[2 * j - 4], mm1 = (j < 2) ? m0[2 * j + 1] : m1[2 * j - 3]; \
          VAL[2 * j] = c0 + mm0 * (0.5f * (p0 + n0) - c0); \
          VAL[2 * j + 1] = c1 + mm1 * (0.5f * (p1 + n1) - c1); } } while (0)
      {
        float val[8];
        SHIFT8(pc0, pp0, pn0, ckA, val);
        float* dst = (ckA < 8) ? Rv : ((ckA < 16) ? KMv : Vv);
        *(f32x4*)(dst + tokA * 64 + (ckA & 7) * 8) = (f32x4){val[0], val[1], val[2], val[3]};
        *(f32x4*)(dst + tokA * 64 + (ckA & 7) * 8 + 4) = (f32x4){val[4], val[5], val[6], val[7]};
      }
      if (wid < 4) {
        float val[8];
        SHIFT8(pc1, pp1, pn1, ckB, val);
        float* dst = (ckB < 8) ? Rv : ((ckB < 16) ? KMv : Vv);
        *(f32x4*)(dst + tokB * 64 + (ckB & 7) * 8) = (f32x4){val[0], val[1], val[2], val[3]};
        *(f32x4*)(dst + tokB * 64 + (ckB & 7) * 8 + 4) = (f32x4){val[4], val[5], val[6], val[7]};
      }
      if (wid < 4) {
        float val[8];
        SHIFT8(pc2, pp2, pn2, ckC, val);
        uint4 o; o.x = pk_bf16(tanhf_(val[0]), tanhf_(val[1])); o.y = pk_bf16(tanhf_(val[2]), tanhf_(val[3]));
        o.z = pk_bf16(tanhf_(val[4]), tanhf_(val[5])); o.w = pk_bf16(tanhf_(val[6]), tanhf_(val[7]));
        *(uint4*)(TW + tokC * 72 + (ckC - 24) * 8) = o;
      } else if (wid < 6) {
        float val[8];
        SHIFT8(pc2, pp2, pn2, ckC, val);
        uint4 o; o.x = pk_bf16(val[0], val[1]); o.y = pk_bf16(val[2], val[3]); o.z = pk_bf16(val[4], val[5]); o.w = pk_bf16(val[6], val[7]);
        *(uint4*)(AL + tokC * 40 + (ckC - 32) * 8) = o;
      }
#undef SHIFT8
      if (ci + 1 < 64) SCAN_LOAD_ALL(ci + 1);
      __syncthreads();
      {
        const int mt = wid >> 2, nt = wid & 3;
        f32x4 accw = (f32x4){0.f, 0.f, 0.f, 0.f}, acca = (f32x4){0.f, 0.f, 0.f, 0.f};
#pragma unroll
        for (int ks = 0; ks < 2; ++ks) {
          const bf16x8 a_op = *(const bf16x8*)(TW + (mt * 16 + fr) * 72 + ks * 32 + fq * 8);
          const bf16x8 b_op = *(const bf16x8*)(WupT + (nt * 16 + fr) * 72 + ks * 32 + fq * 8);
          accw = __builtin_amdgcn_mfma_f32_16x16x32_bf16(a_op, b_op, accw, 0, 0, 0);
        }
        {
          const bf16x8 a_op = *(const bf16x8*)(AL + (mt * 16 + fr) * 40 + fq * 8);
          const bf16x8 b_op = *(const bf16x8*)(AupT + (nt * 16 + fr) * 40 + fq * 8);
          acca = __builtin_amdgcn_mfma_f32_16x16x32_bf16(a_op, b_op, acca, 0, 0, 0);
        }
#pragma unroll
        for (int r = 0; r < 4; ++r) {
          WP[(mt * 16 + fq * 4 + r) * 64 + nt * 16 + fr] = accw[r];
          AP[(mt * 16 + fq * 4 + r) * 64 + nt * 16 + fr] = acca[r];
        }
      }
      __syncthreads();
      {
        const f32x4 wp = *(const f32x4*)(WP + ptok * 64 + pc4);
        const f32x4 ap = *(const f32x4*)(AP + ptok * 64 + pc4);
        const f32x4 kr = *(const f32x4*)(KMv + ptok * 64 + pc4);
        const f32x4 rv = *(const f32x4*)(Rv + ptok * 64 + pc4);
        f32x2 kkv[2], av[2], lwv[2], kmv[2];
        f32x2 ssq2 = (f32x2){0.f, 0.f}, bet2 = (f32x2){0.f, 0.f};
#pragma unroll
        for (int hp = 0; hp < 2; ++hp) {
          const f32x2 wx = (f32x2){w0v[2 * hp], w0v[2 * hp + 1]} + (f32x2){wp[2 * hp], wp[2 * hp + 1]};
          const f32x2 ax = (f32x2){a0v[2 * hp], a0v[2 * hp + 1]} + (f32x2){ap[2 * hp], ap[2 * hp + 1]};
          f32x2 sg, sa_;
          sg[0] = sigmoidf_(wx[0]); sg[1] = sigmoidf_(wx[1]);
          sa_[0] = sigmoidf_(ax[0]); sa_[1] = sigmoidf_(ax[1]);
          lwv[hp] = sg * (-0.60653065971f);
          av[hp] = sa_;
          const f32x2 k2 = (f32x2){kr[2 * hp], kr[2 * hp + 1]};
          kkv[hp] = k2 * (f32x2){kkc[2 * hp], kkc[2 * hp + 1]};
          ssq2 += kkv[hp] * kkv[hp];
          kmv[hp] = k2 * ((sa_ - 1.f) * (f32x2){kac[2 * hp], kac[2 * hp + 1]} + 1.f);
          bet2 += (f32x2){rv[2 * hp], rv[2 * hp + 1]} * kmv[hp] * (f32x2){rkc[2 * hp], rkc[2 * hp + 1]};
        }
        float ssq = ssq2[0] + ssq2[1], bet = bet2[0] + bet2[1];
        for (int m = 0; m < 1; ++m) {
          ssq += dppf<0xB1>(ssq); bet += dppf<0xB1>(bet);
          ssq += dppf<0x4E>(ssq); bet += dppf<0x4E>(bet);
          ssq += dppf<0x141>(ssq); bet += dppf<0x141>(bet);
          ssq += dppf<0x140>(ssq); bet += dppf<0x140>(bet);
        }
        const float rn = rsqrtf(ssq + 1e-12f);
        const f32x2 kk0 = kkv[0] * rn, kk1 = kkv[1] * rn;
        const f32x2 b0 = kk0 * av[0], b1 = kk1 * av[1];
        *(f32x4*)(KKv + ptok * 64 + pc4) = (f32x4){kk0[0], kk0[1], kk1[0], kk1[1]};
        *(f32x4*)(Bv + ptok * 64 + pc4) = (f32x4){b0[0], b0[1], b1[0], b1[1]};
        *(f32x4*)(KMv + ptok * 64 + pc4) = (f32x4){kmv[0][0], kmv[0][1], kmv[1][0], kmv[1][1]};
        *(f32x4*)(LWv + ptok * 64 + pc4) = (f32x4){lwv[0][0], lwv[0][1], lwv[1][0], lwv[1][1]};
        if ((tid & 15) == 0) {
          const int s = ci * 32 + ptok; const int t = d ? (T_ - 1 - s) : s;
          p.beta[(((size_t)d * NB_ + b) * T_ + t) * 8 + h] = bet;
        }
      }
      asm volatile("s_waitcnt lgkmcnt(0)" ::: "memory");
      __builtin_amdgcn_wave_barrier();
      {
        const int c = lane, tg = wid;
        float lw[4], cs[4];
#pragma unroll
        for (int j = 0; j < 4; ++j) lw[j] = LWv[(4 * tg + j) * 64 + c];
        cs[0] = lw[0]; cs[1] = cs[0] + lw[1]; cs[2] = cs[1] + lw[2]; cs[3] = cs[2] + lw[3];
        GT[tg * 64 + c] = cs[3];
        __syncthreads();
        float offs = 0.f, tot = 0.f;
#pragma unroll
        for (int g2 = 0; g2 < 8; ++g2) { const float gv = GT[g2 * 64 + c]; tot += gv; if (g2 < tg) offs += gv; }
        float bt4[4], kt4[4], vt4[4];
        const float etot = __expf(tot);
        float epv = __expf(offs);
#pragma unroll
        for (int j = 0; j < 4; ++j) {
          const int t = 4 * tg + j;
          const float lg = offs + cs[j];
          const float kap = KKv[t * 64 + c], bb = Bv[t * 64 + c], km = KMv[t * 64 + c], rr = Rv[t * 64 + c];
          vt4[j] = Vv[t * 64 + c];
          const float ep = __expf(lg), em = __builtin_amdgcn_rcpf(ep), ec = etot * em;
          AH[t * 72 + c] = f2bf(-kap * epv);
          BH[t * 72 + c] = f2bf(bb * em);
          KH[t * 72 + c] = f2bf(km * em);
          RH[t * 72 + c] = f2bf(rr * ep);
          bt4[j] = bb * ec; kt4[j] = km * ec;
          epv = ep;
        }
        *(uint2*)(BTT + c * 40 + 4 * tg) = make_uint2(pk_bf16(bt4[0], bt4[1]), pk_bf16(bt4[2], bt4[3]));
        *(uint2*)(KTT + c * 40 + 4 * tg) = make_uint2(pk_bf16(kt4[0], kt4[1]), pk_bf16(kt4[2], kt4[3]));
        *(uint2*)(VT + c * 40 + 4 * tg) = make_uint2(pk_bf16(vt4[0], vt4[1]), pk_bf16(vt4[2], vt4[3]));
        if (tg == 0) GC[c] = etot;
      }
      __syncthreads();
      {
        const int mtx = wid >> 1, it = wid & 1;
        const bf16_t* Pi = (mtx & 1) ? KH : BH;
        const bf16_t* Qt = (mtx < 2) ? AH : RH;
        const bf16x8 pa0 = *(const bf16x8*)(Pi + (it * 16 + fr) * 72 + fq * 8);
        const bf16x8 pa1 = *(const bf16x8*)(Pi + (it * 16 + fr) * 72 + 32 + fq * 8);
#pragma unroll
        for (int tt = 0; tt < 2; ++tt) {
          f32x4 acc = (f32x4){0.f, 0.f, 0.f, 0.f};
          const bf16x8 qb0 = *(const bf16x8*)(Qt + (tt * 16 + fr) * 72 + fq * 8);
          const bf16x8 qb1 = *(const bf16x8*)(Qt + (tt * 16 + fr) * 72 + 32 + fq * 8);
          acc = __builtin_amdgcn_mfma_f32_16x16x32_bf16(pa0, qb0, acc, 0, 0, 0);
          acc = __builtin_amdgcn_mfma_f32_16x16x32_bf16(pa1, qb1, acc, 0, 0, 0);
          const int t = tt * 16 + fr, i0 = it * 16 + fq * 4;
          const int lim = (mtx < 2) ? (t - 1) : t;
          f32x4 mk;
#pragma unroll
          for (int r = 0; r < 4; ++r) mk[r] = (i0 + r <= lim) ? acc[r] : 0.f;
          if (mtx == 0) {
#pragma unroll
            for (int r = 0; r < 4; ++r) { const int i = i0 + r; MAB[t * 32 + (i & 3) * 8 + (i >> 2)] = mk[r]; }
          }
          else {
            bf16_t* Mo = (mtx == 1) ? MAK : ((mtx == 2) ? MRB : MRK);
            *(uint2*)(Mo + t * 40 + i0) = make_uint2(pk_bf16(mk[0], mk[1]), pk_bf16(mk[2], mk[3]));
          }
        }
      }
      const int vt_ = wid >> 1, tt_ = wid & 1;
      f32x4 accY = (f32x4){0.f, 0.f, 0.f, 0.f}, accW = (f32x4){0.f, 0.f, 0.f, 0.f};
      {
        const bf16x8 s0 = *(const bf16x8*)(SB + (vt_ * 16 + fr) * 72 + fq * 8);
        const bf16x8 s1 = *(const bf16x8*)(SB + (vt_ * 16 + fr) * 72 + 32 + fq * 8);
        const bf16x8 a0 = *(const bf16x8*)(AH + (tt_ * 16 + fr) * 72 + fq * 8);
        const bf16x8 a1 = *(const bf16x8*)(AH + (tt_ * 16 + fr) * 72 + 32 + fq * 8);
        const bf16x8 r0 = *(const bf16x8*)(RH + (tt_ * 16 + fr) * 72 + fq * 8);
        const bf16x8 r1 = *(const bf16x8*)(RH + (tt_ * 16 + fr) * 72 + 32 + fq * 8);
        accW = __builtin_amdgcn_mfma_f32_16x16x32_bf16(s0, a0, accW, 0, 0, 0);
        accW = __builtin_amdgcn_mfma_f32_16x16x32_bf16(s1, a1, accW, 0, 0, 0);
        accY = __builtin_amdgcn_mfma_f32_16x16x32_bf16(s0, r0, accY, 0, 0, 0);
        accY = __builtin_amdgcn_mfma_f32_16x16x32_bf16(s1, r1, accY, 0, 0, 0);
      }
      __syncthreads();
      {
        const bf16x8 vv = *(const bf16x8*)(VT + (vt_ * 16 + fr) * 40 + fq * 8);
        const bf16x8 mak = *(const bf16x8*)(MAK + (tt_ * 16 + fr) * 40 + fq * 8);
        const bf16x8 mrk = *(const bf16x8*)(MRK + (tt_ * 16 + fr) * 40 + fq * 8);
        accW = __builtin_amdgcn_mfma_f32_16x16x32_bf16(vv, mak, accW, 0, 0, 0);
        accY = __builtin_amdgcn_mfma_f32_16x16x32_bf16(vv, mrk, accY, 0, 0, 0);
        *(f32x4*)(Wb + (tt_ * 16 + fr) * 68 + vt_ * 16 + fq * 4) = accW;
      }
      __syncthreads();
      if (wid < 4) {
        const int q = lane & 3, v = wid * 16 + (lane >> 2);
        f32x2 u01 = (f32x2){0.f, 0.f}, u23 = (f32x2){0.f, 0.f}, u45 = (f32x2){0.f, 0.f}, u67 = (f32x2){0.f, 0.f};
        f32x4 Am0[4], Am1[4], Bm0[4], Bm1[4]; float Aw[4], Bw[4];
#define P6_LOAD(X, T0) do { _Pragma("unroll") for (int s_ = 0; s_ < 4; ++s_) { const int t_ = (T0) + s_; \
          X##m0[s_] = *(const f32x4*)(MAB + t_ * 32 + q * 8); X##m1[s_] = *(const f32x4*)(MAB + t_ * 32 + q * 8 + 4); X##w[s_] = Wb[t_ * 68 + v]; } } while (0)
#define P6_STEPS(X, T0) do { _Pragma("unroll") for (int s_ = 0; s_ < 4; ++s_) { const int t_ = (T0) + s_; \
          f32x2 pa_ = u01 * (f32x2){X##m0[s_][0], X##m0[s_][1]} + u45 * (f32x2){X##m1[s_][0], X##m1[s_][1]}; \
          f32x2 pb_ = u23 * (f32x2){X##m0[s_][2], X##m0[s_][3]} + u67 * (f32x2){X##m1[s_][2], X##m1[s_][3]}; \
          pa_ += pb_; \
          float part = pa_[0] + pa_[1]; \
          part += dppf<0xB1>(part); part += dppf<0x4E>(part); \
          const float ut = X##w[s_] + part; \
          const bool mine = (q == (t_ & 3)); const int j_ = t_ >> 2; \
          if (j_ == 0) u01[0] = mine ? ut : u01[0]; else if (j_ == 1) u01[1] = mine ? ut : u01[1]; \
          else if (j_ == 2) u23[0] = mine ? ut : u23[0]; else if (j_ == 3) u23[1] = mine ? ut : u23[1]; \
          else if (j_ == 4) u45[0] = mine ? ut : u45[0]; else if (j_ == 5) u45[1] = mine ? ut : u45[1]; \
          else if (j_ == 6) u67[0] = mine ? ut : u67[0]; else u67[1] = mine ? ut : u67[1]; } } while (0)
        P6_LOAD(A, 0);
#pragma unroll
        for (int blk = 0; blk < 8; blk += 2) {
          P6_LOAD(B, (blk + 1) * 4);
          __builtin_amdgcn_sched_barrier(0);
          P6_STEPS(A, blk * 4);
          __builtin_amdgcn_sched_barrier(0);
          if (blk + 2 < 8) P6_LOAD(A, (blk + 2) * 4);
          __builtin_amdgcn_sched_barrier(0);
          P6_STEPS(B, (blk + 1) * 4);
          __builtin_amdgcn_sched_barrier(0);
        }
#undef P6_LOAD
#undef P6_STEPS
        bf16_t* up = UT + v * 40 + q;
        up[0] = f2bf(u01[0]); up[4] = f2bf(u01[1]); up[8] = f2bf(u23[0]); up[12] = f2bf(u23[1]);
        up[16] = f2bf(u45[0]); up[20] = f2bf(u45[1]); up[24] = f2bf(u67[0]); up[28] = f2bf(u67[1]);
      }
      __syncthreads();
      {
        const bf16x8 uu = *(const bf16x8*)(UT + (vt_ * 16 + fr) * 40 + fq * 8);
        const bf16x8 mrb = *(const bf16x8*)(MRB + (tt_ * 16 + fr) * 40 + fq * 8);
        accY = __builtin_amdgcn_mfma_f32_16x16x32_bf16(uu, mrb, accY, 0, 0, 0);
        const int s = ci * 32 + tt_ * 16 + fr; const int t = d ? (T_ - 1 - s) : s;
        *(uint2*)(p.ys + ((size_t)d * NTOK + (size_t)b * T_ + t) * 512 + h * 64 + vt_ * 16 + fq * 4) = make_uint2(pk_bf16(accY[0], accY[1]), pk_bf16(accY[2], accY[3]));
        const int kt_ = wid >> 1;
        const f32x4 gc = *(const f32x4*)(GC + kt_ * 16 + fq * 4);
        const bf16x8 bt = *(const bf16x8*)(BTT + (kt_ * 16 + fr) * 40 + fq * 8);
        const bf16x8 ktv = *(const bf16x8*)(KTT + (kt_ * 16 + fr) * 40 + fq * 8);
#pragma unroll
        for (int j = 0; j < 2; ++j) {
          const int v2 = (wid & 1) * 2 + j;
          const bf16x8 u2 = *(const bf16x8*)(UT + (v2 * 16 + fr) * 40 + fq * 8);
          const bf16x8 vv2 = *(const bf16x8*)(VT + (v2 * 16 + fr) * 40 + fq * 8);
          accS[j] = accS[j] * gc;
          accS[j] = __builtin_amdgcn_mfma_f32_16x16x32_bf16(bt, u2, accS[j], 0, 0, 0);
          accS[j] = __builtin_amdgcn_mfma_f32_16x16x32_bf16(ktv, vv2, accS[j], 0, 0, 0);
          *(uint2*)(SB + (v2 * 16 + fr) * 72 + kt_ * 16 + fq * 4) = make_uint2(pk_bf16(accS[j][0], accS[j][1]), pk_bf16(accS[j][2], accS[j][3]));
        }
      }
    }
  }
#undef SCAN_LD
#undef SCAN_ITEMS
#undef SCAN_LOAD_ALL
}

__device__ __forceinline__ void phase_rwkv_fin(const Params& p) {
  const int lane = threadIdx.x & 63, wid = threadIdx.x >> 6;
  const int ch0 = lane * 8, h = lane >> 3;
  float gng[8], gnb[8], muv[8];
#pragma unroll
  for (int j = 0; j < 8; ++j) { gng[j] = p.gn_g[ch0 + j]; gnb[j] = p.gn_b[ch0 + j]; muv[j] = p.mu[1024 + ch0 + j]; }
  const int stride = gridDim.x * 8;
  for (int tok0 = blockIdx.x * 8 + wid; tok0 < NTOK; tok0 += 2 * stride) {
    f32x4 ya0[2], ya1[2], yb0[2], yb1[2]; uint4 zc4[2], zp4[2], zn4[2], g4[2]; float bet[2];
#pragma unroll
    for (int r = 0; r < 2; ++r) {
      const int tok = tok0 + r * stride;
      if (tok < NTOK) {
        const int b = tok >> 11, t = tok & 2047;
        {
          const uint4 qa = *(const uint4*)(p.ys + (size_t)tok * 512 + ch0), qb = *(const uint4*)(p.ys + ((size_t)NTOK + tok) * 512 + ch0);
          ya0[r] = (f32x4){__uint_as_float(qa.x << 16), __uint_as_float(qa.x & 0xffff0000u), __uint_as_float(qa.y << 16), __uint_as_float(qa.y & 0xffff0000u)};
          ya1[r] = (f32x4){__uint_as_float(qa.z << 16), __uint_as_float(qa.z & 0xffff0000u), __uint_as_float(qa.w << 16), __uint_as_float(qa.w & 0xffff0000u)};
          yb0[r] = (f32x4){__uint_as_float(qb.x << 16), __uint_as_float(qb.x & 0xffff0000u), __uint_as_float(qb.y << 16), __uint_as_float(qb.y & 0xffff0000u)};
          yb1[r] = (f32x4){__uint_as_float(qb.z << 16), __uint_as_float(qb.z & 0xffff0000u), __uint_as_float(qb.w << 16), __uint_as_float(qb.w & 0xffff0000u)};
        }
        const bf16_t* zp_ = p.proj + (size_t)tok * N0P + 2560 + ch0;
        zc4[r] = *(const uint4*)zp_;
        zp4[r] = make_uint4(0u, 0u, 0u, 0u); zn4[r] = make_uint4(0u, 0u, 0u, 0u);
        if (t > 0) zp4[r] = *(const uint4*)(zp_ - N0P);
        if (t < T_ - 1) zn4[r] = *(const uint4*)(zp_ + N0P);
        g4[r] = *(const uint4*)(p.proj + (size_t)tok * N0P + 3264 + ch0);
        bet[r] = 0.5f * (p.beta[((size_t)b * T_ + t) * 8 + h] + p.beta[(((size_t)NB_ + b) * T_ + t) * 8 + h]);
      }
    }
#pragma unroll
    for (int r = 0; r < 2; ++r) {
      const int tok = tok0 + r * stride;
      if (tok < NTOK) {
        float y[8];
#pragma unroll
        for (int j = 0; j < 4; ++j) { y[j] = ya0[r][j] + yb0[r][j]; y[4 + j] = ya1[r][j] + yb1[r][j]; }
        float sm = 0.f;
#pragma unroll
        for (int j = 0; j < 8; ++j) sm += y[j];
        sm += dppf0<0xB1>(sm); sm += dppf0<0x4E>(sm); sm += dppf0<0x141>(sm);
        const float mean = sm * (1.f / 64.f);
        float sq = 0.f;
#pragma unroll
        for (int j = 0; j < 8; ++j) { y[j] -= mean; sq += y[j] * y[j]; }
        sq += dppf0<0xB1>(sq); sq += dppf0<0x4E>(sq); sq += dppf0<0x141>(sq);
        const float rstd = rsqrtf(sq * (1.f / 64.f) + 64e-5f);
        const unsigned zcw[4] = {zc4[r].x, zc4[r].y, zc4[r].z, zc4[r].w}, zpw[4] = {zp4[r].x, zp4[r].y, zp4[r].z, zp4[r].w};
        const unsigned znw[4] = {zn4[r].x, zn4[r].y, zn4[r].z, zn4[r].w}, gw[4] = {g4[r].x, g4[r].y, g4[r].z, g4[r].w};
        float o[8];
#pragma unroll
        for (int j = 0; j < 4; ++j) {
#pragma unroll
          for (int e = 0; e < 2; ++e) {
            const int jj = 2 * j + e;
            const float zc = e ? __uint_as_float(zcw[j] & 0xffff0000u) : __uint_as_float(zcw[j] << 16);
            const float zp = e ? __uint_as_float(zpw[j] & 0xffff0000u) : __uint_as_float(zpw[j] << 16);
            const float zn = e ? __uint_as_float(znw[j] & 0xffff0000u) : __uint_as_float(znw[j] << 16);
            const float g = e ? __uint_as_float(gw[j] & 0xffff0000u) : __uint_as_float(gw[j] << 16);
            const float vs = zc + muv[jj] * (0.5f * (zp + zn) - zc);
            const float yn = y[jj] * rstd * gng[jj] + gnb[jj];
            o[jj] = (yn + bet[r] * vs) * siluf_(g);
          }
        }
        *(uint4*)(p.ycat + (size_t)tok * DM + 512 + ch0) = make_uint4(pk_bf16(o[0], o[1]), pk_bf16(o[2], o[3]), pk_bf16(o[4], o[5]), pk_bf16(o[6], o[7]));
      }
    }
  }
}

template <bool XBF>
__device__ __forceinline__ void phase_ln(const void* xin_, const bf16_t* hb, float* yout, const float* __restrict__ g, const float* __restrict__ bb, bf16_t* ob) {
  const float* xin = (const float*)xin_; const bf16_t* xinb = (const bf16_t*)xin_;
  const int lane = threadIdx.x & 63, wid = threadIdx.x >> 6;
  const int stride = gridDim.x * 8;
  f32x4 gg[4], b4[4];
#pragma unroll
  for (int i = 0; i < 2; ++i) { const int c = lane * 8 + 512 * i; gg[2 * i] = *(const f32x4*)(g + c); gg[2 * i + 1] = *(const f32x4*)(g + c + 4); b4[2 * i] = *(const f32x4*)(bb + c); b4[2 * i + 1] = *(const f32x4*)(bb + c + 4); }
  for (int row0 = blockIdx.x * 8 + wid; row0 < NTOK; row0 += 2 * stride) {
    f32x4 xv[2][4]; uint4 hv[2][2];
#pragma unroll
    for (int r = 0; r < 2; ++r) {
      const int row = row0 + r * stride;
      if (row < NTOK) {
#pragma unroll
        for (int i = 0; i < 2; ++i) {
          const int c = lane * 8 + 512 * i;
          if (XBF) {
            const uint4 xq = *(const uint4*)(xinb + (size_t)row * DM + c);
            xv[r][2 * i] = (f32x4){__uint_as_float(xq.x << 16), __uint_as_float(xq.x & 0xffff0000u), __uint_as_float(xq.y << 16), __uint_as_float(xq.y & 0xffff0000u)};
            xv[r][2 * i + 1] = (f32x4){__uint_as_float(xq.z << 16), __uint_as_float(xq.z & 0xffff0000u), __uint_as_float(xq.w << 16), __uint_as_float(xq.w & 0xffff0000u)};
          } else {
            xv[r][2 * i] = *(const f32x4*)(xin + (size_t)row * DM + c); xv[r][2 * i + 1] = *(const f32x4*)(xin + (size_t)row * DM + c + 4);
          }
          hv[r][i] = *(const uint4*)(hb + (size_t)row * DM + c);
        }
      }
    }
#pragma unroll
    for (int r = 0; r < 2; ++r) {
      const int row = row0 + r * stride;
      if (row < NTOK) {
        float v[16]; float s = 0.f;
#pragma unroll
        for (int i = 0; i < 2; ++i) {
          const unsigned hw[4] = {hv[r][i].x, hv[r][i].y, hv[r][i].z, hv[r][i].w};
#pragma unroll
          for (int j = 0; j < 4; ++j) {
            const float xa = (j < 2) ? xv[r][2 * i][2 * j] : xv[r][2 * i + 1][2 * j - 4], xb2 = (j < 2) ? xv[r][2 * i][2 * j + 1] : xv[r][2 * i + 1][2 * j - 3];
            v[8 * i + 2 * j] = ALPHA * xa + __uint_as_float(hw[j] << 16);
            v[8 * i + 2 * j + 1] = ALPHA * xb2 + __uint_as_float(hw[j] & 0xffff0000u);
            s += v[8 * i + 2 * j] + v[8 * i + 2 * j + 1];
          }
        }
        const float mean = wave_sum(s) * (1.f / 1024.f);
        float q = 0.f;
#pragma unroll
        for (int i = 0; i < 16; ++i) { v[i] -= mean; q += v[i] * v[i]; }
        const float rstd = rsqrtf(wave_sum(q) * (1.f / 1024.f) + 1e-5f);
#pragma unroll
        for (int i = 0; i < 2; ++i) {
          const int c = lane * 8 + 512 * i;
          f32x4 o0, o1;
#pragma unroll
          for (int j = 0; j < 4; ++j) { o0[j] = v[8 * i + j] * rstd * gg[2 * i][j] + b4[2 * i][j]; o1[j] = v[8 * i + 4 + j] * rstd * gg[2 * i + 1][j] + b4[2 * i + 1][j]; }
          if (yout) { *(f32x4*)(yout + (size_t)row * DM + c) = o0; *(f32x4*)(yout + (size_t)row * DM + c + 4) = o1; }
          if (ob) *(uint4*)(ob + (size_t)row * DM + c) = make_uint4(pk_bf16(o0[0], o0[1]), pk_bf16(o0[2], o0[3]), pk_bf16(o1[0], o1[1]), pk_bf16(o1[2], o1[3]));
        }
      }
    }
  }
}

__device__ __forceinline__ int swz64(int row, int ch) { return row * 64 + ((ch ^ ((row >> 1) & 7)) << 3); }

__device__ __forceinline__ void phase_gla(const Params& p, char* smem) {
  bf16_t* QT = (bf16_t*)smem;
  bf16_t* KT = QT + 64 * 136;
  bf16_t* KRT = KT + 64 * 136;
  bf16_t* VT = KRT + 128 * 72;
  bf16_t* PP = VT + 128 * 72;
  bf16_t* ST = PP + 64 * 72;
  float* LR = (float*)(ST + 128 * 136);
  float* GT = LR + 1024;
  float* DEC = GT + 1024;
  float* LR1 = DEC + 128;
  const int tid = threadIdx.x, lane = tid & 63, wid = tid >> 6;
  const int fr = lane & 15, fq = lane >> 4;
  const int c2 = tid & 63, tg = tid >> 6;
  for (int item = blockIdx.x; item < 256; item += gridDim.x) {
    const int d = item >> 7, b = (item >> 3) & 15, h = (item >> 1) & 3, vh = item & 1;
    __syncthreads();
    for (int i = tid; i < 128 * 136 / 2; i += NTHR) ((unsigned*)ST)[i] = 0u;
    f32x2 gup2[16];
#pragma unroll
    for (int r = 0; r < 16; ++r) gup2[r] = *(const f32x2*)(p.g_up + ((size_t)d * 16 + r) * 512 + h * 128 + 2 * c2);
    const f32x2 gb2 = *(const f32x2*)(p.g_bias + d * 512 + h * 128 + 2 * c2);
    f32x4 accs[8];
#pragma unroll
    for (int i = 0; i < 8; ++i) accs[i] = (f32x4){0.f, 0.f, 0.f, 0.f};
    const bf16_t* pbase = p.proj + (size_t)b * T_ * N1P;
    bf16_t lrr[2]; unsigned qr[8], kr[8], vr[8];
#define GLA_LOAD_RAW(CI) do { \
      _Pragma("unroll") for (int i2_ = 0; i2_ < 2; ++i2_) { \
        const int e_ = tid + 512 * i2_; const int tok_ = e_ >> 4, r_ = e_ & 15; \
        const int s_ = (CI) * 64 + tok_; const int t_ = d ? (T_ - 1 - s_) : s_; \
        lrr[i2_] = pbase[(size_t)t_ * N1P + 3072 + d * 16 + r_]; } \
      _Pragma("unroll") for (int ii_ = 0; ii_ < 8; ++ii_) { \
        const int s_ = (CI) * 64 + tg * 8 + ii_; const int t_ = d ? (T_ - 1 - s_) : s_; \
        const bf16_t* rowp_ = pbase + (size_t)t_ * N1P; \
        qr[ii_] = *(const unsigned*)(rowp_ + h * 128 + 2 * c2); kr[ii_] = *(const unsigned*)(rowp_ + 512 + h * 128 + 2 * c2); \
        vr[ii_] = *(const unsigned*)(rowp_ + 1024 + h * 256 + vh * 128 + 2 * c2); } } while (0)
    GLA_LOAD_RAW(0);
    for (int ci = 0; ci < 32; ++ci) {
#pragma unroll
      for (int i2 = 0; i2 < 2; ++i2) { const int e = tid + 512 * i2; LR[(e >> 4) * 16 + (e & 15)] = bf2f(lrr[i2]); }
      __syncthreads();
      f32x2 bl[8]; f32x2 cum = (f32x2){0.f, 0.f};
#pragma unroll
      for (int ii = 0; ii < 8; ++ii) {
        const int i = tg * 8 + ii;
        f32x2 xg = gb2;
#pragma unroll
        for (int r4 = 0; r4 < 4; ++r4) {
          const f32x4 l4 = *(const f32x4*)(LR + i * 16 + r4 * 4);
          xg += (f32x2){l4[0], l4[0]} * gup2[r4 * 4 + 0];
          xg += (f32x2){l4[1], l4[1]} * gup2[r4 * 4 + 1];
          xg += (f32x2){l4[2], l4[2]} * gup2[r4 * 4 + 2];
          xg += (f32x2){l4[3], l4[3]} * gup2[r4 * 4 + 3];
        }
        f32x2 ls;
        ls[0] = fminf(xg[0], 0.f) - 0.69314718056f * __builtin_amdgcn_logf(1.f + __expf(-fabsf(xg[0])));
        ls[1] = fminf(xg[1], 0.f) - 0.69314718056f * __builtin_amdgcn_logf(1.f + __expf(-fabsf(xg[1])));
        cum += ls * (1.f / 16.f);
        bl[ii] = cum;
      }
      *(f32x2*)(GT + (tg * 64 + c2) * 2) = cum;
      __syncthreads();
      {
        f32x2 offs = (f32x2){0.f, 0.f}, total = (f32x2){0.f, 0.f};
#pragma unroll
        for (int g2 = 0; g2 < 8; ++g2) { const f32x2 gv = *(const f32x2*)(GT + (g2 * 64 + c2) * 2); total += gv; if (g2 < tg) offs += gv; }
        f32x2 krv[8];
        f32x2 etot; etot[0] = __expf(total[0]); etot[1] = __expf(total[1]);
#pragma unroll
        for (int ii = 0; ii < 8; ++ii) {
          const int i = tg * 8 + ii;
          const f32x2 bv = bl[ii] + offs;
          f32x2 eb, ebi;
          eb[0] = __expf(bv[0]); eb[1] = __expf(bv[1]);
          ebi[0] = __builtin_amdgcn_rcpf(eb[0]); ebi[1] = __builtin_amdgcn_rcpf(eb[1]);
          const f32x2 qraw = (f32x2){__uint_as_float(qr[ii] << 16), __uint_as_float(qr[ii] & 0xffff0000u)};
          const f32x2 kraw = (f32x2){__uint_as_float(kr[ii] << 16), __uint_as_float(kr[ii] & 0xffff0000u)};
          const f32x2 qv = qraw * 0.08838834764831845f * eb;
          const f32x2 kv = kraw * ebi;
          *(unsigned*)(QT + i * 136 + 2 * c2) = pk_bf16(qv[0], qv[1]);
          *(unsigned*)(KT + i * 136 + 2 * c2) = pk_bf16(kv[0], kv[1]);
          krv[ii] = kv * etot;
        }
        *(uint4*)(KRT + swz64(2 * c2, tg)) = make_uint4(pk_bf16(krv[0][0], krv[1][0]), pk_bf16(krv[2][0], krv[3][0]), pk_bf16(krv[4][0], krv[5][0]), pk_bf16(krv[6][0], krv[7][0]));
        *(uint4*)(KRT + swz64(2 * c2 + 1, tg)) = make_uint4(pk_bf16(krv[0][1], krv[1][1]), pk_bf16(krv[2][1], krv[3][1]), pk_bf16(krv[4][1], krv[5][1]), pk_bf16(krv[6][1], krv[7][1]));
        *(uint4*)(VT + swz64(2 * c2, tg)) = make_uint4((vr[0] & 0xffffu) | (vr[1] << 16), (vr[2] & 0xffffu) | (vr[3] << 16), (vr[4] & 0xffffu) | (vr[5] << 16), (vr[6] & 0xffffu) | (vr[7] << 16));
        *(uint4*)(VT + swz64(2 * c2 + 1, tg)) = make_uint4((vr[0] >> 16) | (vr[1] & 0xffff0000u), (vr[2] >> 16) | (vr[3] & 0xffff0000u), (vr[4] >> 16) | (vr[5] & 0xffff0000u), (vr[6] >> 16) | (vr[7] & 0xffff0000u));
        if (tg == 0) *(f32x2*)(DEC + 2 * c2) = etot;
      }
      if (ci + 1 < 32) GLA_LOAD_RAW(ci + 1);
      __syncthreads();
#pragma unroll
      for (int tt = 0; tt < 2; ++tt) {
        const int tile = wid * 2 + tt; const int it = tile >> 2, jt = tile & 3;
        f32x4 acc = (f32x4){0.f, 0.f, 0.f, 0.f};
#pragma unroll
        for (int ks = 0; ks < 4; ++ks) {
          const bf16x8 a_op = *(const bf16x8*)(KT + (jt * 16 + fr) * 136 + ks * 32 + fq * 8);
          const bf16x8 b_op = *(const bf16x8*)(QT + (it * 16 + fr) * 136 + ks * 32 + fq * 8);
          acc = __builtin_amdgcn_mfma_f32_16x16x32_bf16(a_op, b_op, acc, 0, 0, 0);
        }
        const int i = it * 16 + fr, j0 = jt * 16 + fq * 4;
        const float p0 = (j0 + 0 <= i) ? acc[0] : 0.f, p1 = (j0 + 1 <= i) ? acc[1] : 0.f;
        const float p2 = (j0 + 2 <= i) ? acc[2] : 0.f, p3 = (j0 + 3 <= i) ? acc[3] : 0.f;
        uint2 o; o.x = pk_bf16(p0, p1); o.y = pk_bf16(p2, p3);
        *(uint2*)(PP + swz64(i, j0 >> 3) + (j0 & 7)) = o;
      }
      __syncthreads();
      {
        f32x4 acco[4];
#pragma unroll
        for (int mi = 0; mi < 4; ++mi) acco[mi] = (f32x4){0.f, 0.f, 0.f, 0.f};
#pragma unroll
        for (int ks = 0; ks < 2; ++ks) {
          const bf16x8 a_op = *(const bf16x8*)(VT + swz64(wid * 16 + fr, ks * 4 + fq));
#pragma unroll
          for (int mi = 0; mi < 4; ++mi) {
            const bf16x8 b_op = *(const bf16x8*)(PP + swz64(mi * 16 + fr, ks * 4 + fq));
            acco[mi] = __builtin_amdgcn_mfma_f32_16x16x32_bf16(a_op, b_op, acco[mi], 0, 0, 0);
          }
        }
#pragma unroll
        for (int ks = 0; ks < 4; ++ks) {
          const bf16x8 a_op = *(const bf16x8*)(ST + (wid * 16 + fr) * 136 + ks * 32 + fq * 8);
#pragma unroll
          for (int mi = 0; mi < 4; ++mi) {
            const bf16x8 b_op = *(const bf16x8*)(QT + (mi * 16 + fr) * 136 + ks * 32 + fq * 8);
            acco[mi] = __builtin_amdgcn_mfma_f32_16x16x32_bf16(a_op, b_op, acco[mi], 0, 0, 0);
          }
        }
#pragma unroll
        for (int mi = 0; mi < 4; ++mi) {
          const int i = mi * 16 + fr;
          const int s = ci * 64 + i; const int t = d ? (T_ - 1 - s) : s;
          uint2 o; o.x = pk_bf16(acco[mi][0], acco[mi][1]); o.y = pk_bf16(acco[mi][2], acco[mi][3]);
          *(uint2*)(p.go + ((size_t)d * NTOK + (size_t)b * T_ + t) * DM + h * 256 + vh * 128 + wid * 16 + fq * 4) = o;
        }
      }
      bf16x8 vfr[2];
#pragma unroll
      for (int ks = 0; ks < 2; ++ks) vfr[ks] = *(const bf16x8*)(VT + swz64(wid * 16 + fr, ks * 4 + fq));
#pragma unroll
      for (int ct = 0; ct < 8; ++ct) {
        const f32x4 dec = *(const f32x4*)(DEC + ct * 16 + fq * 4);
        accs[ct] = accs[ct] * dec;
#pragma unroll
        for (int ks = 0; ks < 2; ++ks) {
          const bf16x8 a_op = *(const bf16x8*)(KRT + swz64(ct * 16 + fr, ks * 4 + fq));
          accs[ct] = __builtin_amdgcn_mfma_f32_16x16x32_bf16(a_op, vfr[ks], accs[ct], 0, 0, 0);
        }
        uint2 o; o.x = pk_bf16(accs[ct][0], accs[ct][1]); o.y = pk_bf16(accs[ct][2], accs[ct][3]);
        *(uint2*)(ST + (wid * 16 + fr) * 136 + ct * 16 + fq * 4) = o;
      }
      __syncthreads();
    }
  }
}

__device__ __forceinline__ void phase_gla_fin(const Params& p) {
  const int lane = threadIdx.x & 63, wid = threadIdx.x >> 6;
  const int n0 = lane * 16;
  float ng[16];
#pragma unroll
  for (int j = 0; j < 16; ++j) ng[j] = p.norm_g[n0 + j];
  const int stride = gridDim.x * 8;
  for (int tok0 = blockIdx.x * 8 + wid; tok0 < NTOK; tok0 += 2 * stride) {
    uint4 av[2][2], bv[2][2], gv[2][2];
#pragma unroll
    for (int r = 0; r < 2; ++r) {
      const int tok = tok0 + r * stride;
      if (tok < NTOK) {
        av[r][0] = *(const uint4*)(p.go + (size_t)tok * DM + n0); av[r][1] = *(const uint4*)(p.go + (size_t)tok * DM + n0 + 8);
        bv[r][0] = *(const uint4*)(p.go + ((size_t)NTOK + tok) * DM + n0); bv[r][1] = *(const uint4*)(p.go + ((size_t)NTOK + tok) * DM + n0 + 8);
        gv[r][0] = *(const uint4*)(p.proj + (size_t)tok * N1P + 2048 + n0); gv[r][1] = *(const uint4*)(p.proj + (size_t)tok * N1P + 2048 + n0 + 8);
      }
    }
#pragma unroll
    for (int r = 0; r < 2; ++r) {
      const int tok = tok0 + r * stride;
      if (tok < NTOK) {
        const unsigned aw[8] = {av[r][0].x, av[r][0].y, av[r][0].z, av[r][0].w, av[r][1].x, av[r][1].y, av[r][1].z, av[r][1].w};
        const unsigned bw[8] = {bv[r][0].x, bv[r][0].y, bv[r][0].z, bv[r][0].w, bv[r][1].x, bv[r][1].y, bv[r][1].z, bv[r][1].w};
        const unsigned gw[8] = {gv[r][0].x, gv[r][0].y, gv[r][0].z, gv[r][0].w, gv[r][1].x, gv[r][1].y, gv[r][1].z, gv[r][1].w};
        float o[16]; float sq = 0.f;
#pragma unroll
        for (int j = 0; j < 8; ++j) {
          o[2 * j] = __uint_as_float(aw[j] << 16) + __uint_as_float(bw[j] << 16);
          o[2 * j + 1] = __uint_as_float(aw[j] & 0xffff0000u) + __uint_as_float(bw[j] & 0xffff0000u);
          sq += o[2 * j] * o[2 * j] + o[2 * j + 1] * o[2 * j + 1];
        }
        sq += dppf0<0xB1>(sq); sq += dppf0<0x4E>(sq); sq += dppf0<0x141>(sq); sq += dppf0<0x140>(sq);
        const float rs = rsqrtf(sq * (1.f / 256.f) + 1e-6f);
        unsigned ow[8];
#pragma unroll
        for (int j = 0; j < 8; ++j) {
          const float ga = __uint_as_float(gw[j] << 16), gb2 = __uint_as_float(gw[j] & 0xffff0000u);
          ow[j] = pk_bf16(o[2 * j] * rs * ng[2 * j] * siluf_(ga), o[2 * j + 1] * rs * ng[2 * j + 1] * siluf_(gb2));
        }
        *(uint4*)(p.ycat + (size_t)tok * DM + n0) = make_uint4(ow[0], ow[1], ow[2], ow[3]);
        *(uint4*)(p.ycat + (size_t)tok * DM + n0 + 8) = make_uint4(ow[4], ow[5], ow[6], ow[7]);
      }
    }
  }
}

__device__ __forceinline__ void phase_dump(const Params& p, int mode) {
  for (size_t i = (size_t)blockIdx.x * NTHR + threadIdx.x; i < (size_t)NTOK * DM; i += (size_t)gridDim.x * NTHR) {
    const size_t tok = i >> 10; const int n = (int)(i & 1023);
    float v = 0.f;
    if (mode == 1) {
      v = bf2f(p.proj[tok * N0P + n]) + bf2f(p.proj[tok * N0P + 1024 + n]) + bf2f(p.proj[tok * N0P + 2048 + n]);
      if (n < 768) v += bf2f(p.proj[tok * N0P + 3072 + n]);
    } else if (mode == 2) {
      if (n < 512) v = bf2f(p.ycat[tok * DM + n]);
      else v = bf2f(p.ys[tok * 512 + (n - 512)]) + bf2f(p.ys[((size_t)NTOK + tok) * 512 + (n - 512)]) + ((n < 520) ? p.beta[tok * 8 + (n - 512)] + p.beta[((size_t)NTOK + tok) * 8 + (n - 512)] : 0.f);
    } else if (mode == 3) {
      v = bf2f(p.ycat[tok * DM + n]);
    } else if (mode == 4) {
      v = bf2f(p.xb[i]) + bf2f(p.wt0[i % ((size_t)N0P * DM)]) + bf2f(p.wt1[i % ((size_t)N1P * DM)]) + bf2f(p.wto0[i % ((size_t)DM * DM)]) + bf2f(p.wto1[i % ((size_t)DM * DM)]);
    }
    p.out[i] = v;
  }
}

#define XB_TMO      128
#define XB_XCNT(j)  (256  + 64 * (j))
#define XB_XSUB(j)  (1280 + 64 * (j))
#define XB_XGEN(j)  (2304 + 64 * (j))
#define XB_TOP      3328
#define XB_TOPGEN   3392
#define XCD_BAR_WORDS 3456
#define XB_SPIN_CAP (1u << 18)
#define XB_LAS __attribute__((address_space(3)))
__device__ __forceinline__ unsigned xb_ld(unsigned* p)              { return __hip_atomic_load(p, __ATOMIC_RELAXED, __HIP_MEMORY_SCOPE_AGENT); }
__device__ __forceinline__ unsigned xb_add(unsigned* p, unsigned v) { return __hip_atomic_fetch_add(p, v, __ATOMIC_RELAXED, __HIP_MEMORY_SCOPE_AGENT); }
__device__ __forceinline__ unsigned xb_xcc_id() { return (unsigned)__builtin_amdgcn_s_getreg((3 << 11) | 20) & 0xFu; }
#define XB_SPIN(cond, bar) do { unsigned _sp = 0; while (cond) { __builtin_amdgcn_s_sleep(1); \
    if ((++_sp & 255u) == 0u) { if (xb_ld(&(bar)[XB_TMO])) break; if (_sp > XB_SPIN_CAP) { atomicAdd(&(bar)[XB_TMO], 1u); break; } } } } while (0)
struct XcdBarrier { unsigned* bar; unsigned x; volatile XB_LAS unsigned* st; };
__device__ __forceinline__ XcdBarrier xcd_barrier_post(unsigned* bar, volatile XB_LAS unsigned* st) {
  XcdBarrier b; b.bar = bar; b.x = xb_xcc_id(); b.st = st;
  if (threadIdx.x == 0) (void)xb_add(&bar[XB_XCNT(b.x)], 1u);
  return b;
}
__device__ __forceinline__ void xcd_barrier_complete(unsigned* bar, unsigned x, unsigned& nloc, unsigned& nx) {
  const unsigned G = gridDim.x * gridDim.y * gridDim.z;
  unsigned sum, cnt, mine, sp = 0u;
  for (;;) {
    sum = 0u; cnt = 0u; mine = 0u;
#pragma unroll
    for (unsigned j = 0; j < 16; ++j) { const unsigned c = xb_ld(&bar[XB_XCNT(j)]); sum += c; cnt += (c > 0u) ? 1u : 0u; mine = (j == x) ? c : mine; }
    if (sum == G) break;
    __builtin_amdgcn_s_sleep(1);
    if ((++sp & 255u) == 0u) { if (xb_ld(&bar[XB_TMO])) break; if (sp > XB_SPIN_CAP) { atomicAdd(&bar[XB_TMO], 1u); break; } }
  }
  nloc = mine > 0u ? mine : 1u; nx = cnt > 0u ? cnt : 1u;
}
__device__ __forceinline__ void xcd_barrier(const XcdBarrier& b) {
  asm volatile("s_waitcnt vmcnt(0)" ::: "memory");
  __syncthreads();
  if (threadIdx.x == 0) {
    unsigned* bar = b.bar;
    __builtin_amdgcn_s_waitcnt(0);
    unsigned nloc = b.st[0], nx = b.st[1];
    if (nloc == 0u) { xcd_barrier_complete(bar, b.x, nloc, nx); b.st[0] = nloc; b.st[1] = nx; }
    const unsigned old = xb_add(&bar[XB_XSUB(b.x)], 1u);
    const unsigned gen = old / nloc;
    if (old + 1u == (gen + 1u) * nloc) {
      __builtin_amdgcn_fence(__ATOMIC_RELEASE, "agent");
      asm volatile("s_waitcnt vmcnt(0)" ::: "memory");
      const unsigned og = xb_add(&bar[XB_TOP], 1u);
      const unsigned tg = og / nx;
      if (og + 1u == (tg + 1u) * nx) xb_add(&bar[XB_TOPGEN], 1u);
      else XB_SPIN(xb_ld(&bar[XB_TOPGEN]) == tg, bar);
      __builtin_amdgcn_fence(__ATOMIC_ACQUIRE, "agent");
      xb_add(&bar[XB_XGEN(b.x)], 1u);
      asm volatile("s_waitcnt vmcnt(0)" ::: "memory");
    } else {
      XB_SPIN(xb_ld(&bar[XB_XGEN(b.x)]) == gen, bar);
      __builtin_amdgcn_fence(__ATOMIC_ACQUIRE, "agent");
      asm volatile("s_waitcnt vmcnt(0)" ::: "memory");
    }
  }
  __syncthreads();
}

__global__ void __launch_bounds__(NTHR) mega(Params p) {
  __shared__ __attribute__((aligned(16))) char smem[LDS_BYTES];
  cg::grid_group grid = cg::this_grid();
  if (threadIdx.x == 0) *(uint4*)(smem + LDS_BYTES - 16) = make_uint4(0u, 0u, 0u, 0u);
  __syncthreads();
  const XcdBarrier xb = xcd_barrier_post(p.bar, (volatile XB_LAS unsigned*)(smem + LDS_BYTES - 16));
  if (p.ph_hi > 1000) grid.sync();
#define RUN_PHASE(PH, CALL) \
  if (p.ph_lo <= (PH) && (PH) <= p.ph_hi) { CALL; } \
  if (p.ph_lo <= (PH) && (PH) < p.ph_hi) xcd_barrier(xb);
  RUN_PHASE(0, phase_prep(p, smem))
  RUN_PHASE(1, gemm_run(p.xb, p.wt0, N0P, pg8::EpiBf16{p.proj, N0P}, smem))
  RUN_PHASE(2, phase_conv(p, smem); phase_scan(p, smem))
  RUN_PHASE(3, phase_rwkv_fin(p))
  RUN_PHASE(4, gemm_run(p.ycat, p.wto0, DM, pg8::EpiBf16{p.hb, DM}, smem))
  RUN_PHASE(5, phase_ln<true>(p.xb, p.hb, nullptr, p.ln0_g, p.ln0_b, p.x1k))
  RUN_PHASE(6, gemm_run(p.x1k, p.wt1, N1P, pg8::EpiBf16{p.proj, N1P}, smem))
  RUN_PHASE(7, phase_gla(p, smem))
  RUN_PHASE(8, phase_gla_fin(p))
  RUN_PHASE(9, gemm_run(p.ycat, p.wto1, DM, pg8::EpiBf16{p.hb, DM}, smem))
  RUN_PHASE(10, phase_ln<true>(p.x1k, p.hb, p.out, p.ln1_g, p.ln1_b, nullptr))
  RUN_PHASE(11, phase_dump(p, DUMPMODE))
}

extern "C" void kernel_launch(void* const* d_in, const int* in_sizes, int n_in, void* d_out, int out_size,
                              void* d_ws, size_t ws_size, hipStream_t stream) {
  Params p{};
  p.x = (const float*)d_in[0]; p.w_in0 = (const float*)d_in[1]; p.conv_w = (const float*)d_in[2]; p.conv_b = (const float*)d_in[3];
  p.conv_ln_g = (const float*)d_in[4]; p.conv_ln_b = (const float*)d_in[5]; p.mu = (const float*)d_in[6]; p.w0 = (const float*)d_in[7];
  p.w_up = (const float*)d_in[8]; p.a0 = (const float*)d_in[9]; p.a_up = (const float*)d_in[10]; p.k_k = (const float*)d_in[11];
  p.k_a = (const float*)d_in[12]; p.r_k = (const float*)d_in[13]; p.gn_g = (const float*)d_in[14]; p.gn_b = (const float*)d_in[15];
  p.w_out0 = (const float*)d_in[16]; p.ln0_g = (const float*)d_in[17]; p.ln0_b = (const float*)d_in[18];
  p.w_in1 = (const float*)d_in[19]; p.g_up = (const float*)d_in[20]; p.g_bias = (const float*)d_in[21]; p.norm_g = (const float*)d_in[22];
  p.w_out1 = (const float*)d_in[23]; p.ln1_g = (const float*)d_in[24]; p.ln1_b = (const float*)d_in[25];
  p.out = (float*)d_out;
  char* ws = (char*)d_ws;
  size_t off = 0;
  p.xb = (bf16_t*)(ws + off); p.ys = (bf16_t*)(ws + off + ((size_t)64 << 20)); p.go = (bf16_t*)(ws + off); p.hb = (bf16_t*)(ws + off + ((size_t)64 << 20)); off += (size_t)128 << 20;
  p.wt0 = (bf16_t*)(ws + off); off += (size_t)N0P * DM * 2;
  p.wto0 = (bf16_t*)(ws + off); off += (size_t)DM * DM * 2;
  p.wt1 = (bf16_t*)(ws + off); off += (size_t)N1P * DM * 2;
  p.wto1 = (bf16_t*)(ws + off); off += (size_t)DM * DM * 2;
  p.ycat = (bf16_t*)(ws + off); off += (size_t)NTOK * DM * 2;
  p.beta = (float*)(ws + off); off += (size_t)2 * NB_ * T_ * 8 * 4;
  p.proj = (bf16_t*)(ws + off);
  p.x1k = (bf16_t*)(ws + off + (size_t)NTOK * N1P * 2);
  p.bar = (unsigned*)(ws + ((size_t)496 << 20));
  p.ph_lo = 0; p.ph_hi = 10;
  static int grid_blocks = 0;
  if (!grid_blocks) {
    int dev = 0, cus = 0, per_cu = 0;
    hipGetDevice(&dev);
    hipDeviceGetAttribute(&cus, hipDeviceAttributeMultiprocessorCount, dev);
    hipOccupancyMaxActiveBlocksPerMultiprocessor(&per_cu, mega, NTHR, 0);
    if (per_cu < 1) per_cu = 1;
    if (per_cu > 1) per_cu = 1;
    grid_blocks = cus * per_cu;
  }
#ifdef MULTI_LAUNCH
  for (int ph = 0; ph <= MAXPH; ++ph) {
    p.ph_lo = ph; p.ph_hi = ph;
    hipLaunchKernelGGL(mega, dim3(grid_blocks), dim3(NTHR), 0, stream, p);
  }
  p.ph_lo = 11; p.ph_hi = 11;
  hipLaunchKernelGGL(mega, dim3(grid_blocks), dim3(NTHR), 0, stream, p);
#else
  (void)hipMemsetAsync(p.bar, 0, XCD_BAR_WORDS * sizeof(unsigned), stream);
  void* args[] = {&p};
  hipError_t e = hipLaunchCooperativeKernel((void*)mega, dim3(grid_blocks), dim3(NTHR), args, 0, stream);
  if (e != hipSuccess) fprintf(stderr, "cooperative launch failed: %s (grid %d)\n", hipGetErrorString(e), grid_blocks);
#endif
}
```

```cpp
#include <hip/hip_runtime.h>
#include <hip/hip_cooperative_groups.h>
#include <cstdio>
namespace cg = cooperative_groups;

typedef unsigned short bf16_t;
typedef short bf16x8 __attribute__((ext_vector_type(8)));
typedef float f32x4 __attribute__((ext_vector_type(4)));
typedef float f32x2 __attribute__((ext_vector_type(2)));

#define T_ 2048
#define NB_ 16
#define NTOK 32768
#define DM 1024
#define N0 3776
#define N0P 3840
#define N1 3104
#define N1P 3328
#define ALPHA 1.41421356237f
#define NTHR 512
#define LDS_BYTES 139264

#define MAXPH 1
#define DUMPMODE 1

struct Params {
  const float* x; const float* w_in0; const float* conv_w; const float* conv_b; const float* conv_ln_g; const float* conv_ln_b;
  const float* mu; const float* w0; const float* w_up; const float* a0; const float* a_up; const float* k_k; const float* k_a; const float* r_k;
  const float* gn_g; const float* gn_b; const float* w_out0; const float* ln0_g; const float* ln0_b;
  const float* w_in1; const float* g_up; const float* g_bias; const float* norm_g; const float* w_out1; const float* ln1_g; const float* ln1_b;
  float* out;
  bf16_t* xb; bf16_t* ys; bf16_t* go; bf16_t* hb;
  bf16_t* wt0; bf16_t* wto0; bf16_t* wt1; bf16_t* wto1;
  bf16_t* proj; bf16_t* ycat; float* beta; bf16_t* x1k; unsigned* bar;
  int ph_lo; int ph_hi;
};

typedef __bf16 bf16x2_t __attribute__((ext_vector_type(2)));
__device__ __forceinline__ unsigned pk_bf16(float lo, float hi) {
  const f32x2 v = (f32x2){lo, hi};
  const bf16x2_t b = __builtin_convertvector(v, bf16x2_t);
  return __builtin_bit_cast(unsigned, b);
}
__device__ __forceinline__ bf16_t f2bf(float v) { return (bf16_t)(pk_bf16(v, 0.f) & 0xffffu); }
__device__ __forceinline__ float bf2f(bf16_t v) { return __uint_as_float(((unsigned)v) << 16); }
__device__ __forceinline__ float sigmoidf_(float x) { return __builtin_amdgcn_rcpf(1.f + __expf(-x)); }
__device__ __forceinline__ float siluf_(float x) { return x * __builtin_amdgcn_rcpf(1.f + __expf(-x)); }
__device__ __forceinline__ float tanhf_(float x) { return 1.f - 2.f * __builtin_amdgcn_rcpf(1.f + __expf(2.f * x)); }
template <int CTRL> __device__ __forceinline__ float dppf0(float x) {
  return __int_as_float(__builtin_amdgcn_update_dpp(0, __float_as_int(x), CTRL, 0xF, 0xF, true));
}
__device__ __forceinline__ float wave_sum(float v) {
  v += dppf0<0xB1>(v); v += dppf0<0x4E>(v); v += dppf0<0x141>(v); v += dppf0<0x140>(v);
  const int vi = __float_as_int(v);
  const float r0 = __int_as_float(__builtin_amdgcn_readlane(vi, 0)), r1 = __int_as_float(__builtin_amdgcn_readlane(vi, 16));
  const float r2 = __int_as_float(__builtin_amdgcn_readlane(vi, 32)), r3 = __int_as_float(__builtin_amdgcn_readlane(vi, 48));
  return (r0 + r1) + (r2 + r3);
}
template <int CTRL> __device__ __forceinline__ float dppf(float x) {
  return __int_as_float(__builtin_amdgcn_update_dpp(0, __float_as_int(x), CTRL, 0xF, 0xF, true));
}

__device__ __forceinline__ void wtrans_tile(const float* __restrict__ W, int N, bf16_t* __restrict__ Wt, int kt, int nt, float* tile) {
  const int tid = threadIdx.x;
  const int k0 = kt * 64, n0 = nt * 64;
  {
    const int r = tid >> 4, c4 = (tid & 15) * 4;
#pragma unroll
    for (int hh = 0; hh < 2; ++hh) {
      const int rr = r + hh * 32;
      float4 v = make_float4(0.f, 0.f, 0.f, 0.f);
      if (n0 + c4 < N) v = *(const float4*)(W + (size_t)(k0 + rr) * N + n0 + c4);
      tile[rr * 65 + c4 + 0] = v.x; tile[rr * 65 + c4 + 1] = v.y; tile[rr * 65 + c4 + 2] = v.z; tile[rr * 65 + c4 + 3] = v.w;
    }
  }
  __syncthreads();
  {
    const int n = tid >> 3, k8 = (tid & 7) * 8;
    float v[8];
#pragma unroll
    for (int i = 0; i < 8; ++i) v[i] = tile[(k8 + i) * 65 + n];
    uint4 o; o.x = pk_bf16(v[0], v[1]); o.y = pk_bf16(v[2], v[3]); o.z = pk_bf16(v[4], v[5]); o.w = pk_bf16(v[6], v[7]);
    *(uint4*)(Wt + (size_t)(n0 + n) * DM + k0 + k8) = o;
  }
  __syncthreads();
}

__device__ __forceinline__ void phase_prep(const Params& p, char* smem) {
  const size_t n8 = (size_t)NTOK * DM / 8;
  for (size_t i = (size_t)blockIdx.x * NTHR + threadIdx.x; i < n8; i += (size_t)gridDim.x * NTHR) {
    const float4* src = (const float4*)(p.x) + i * 2;
    float4 a = src[0], b = src[1];
    uint4 o; o.x = pk_bf16(a.x, a.y); o.y = pk_bf16(a.z, a.w); o.z = pk_bf16(b.x, b.y); o.w = pk_bf16(b.z, b.w);
    ((uint4*)p.xb)[i] = o;
  }
  float* tile = (float*)smem;
  for (int u = blockIdx.x; u < 2304; u += gridDim.x) {
    if (u < 960) wtrans_tile(p.w_in0, N0, p.wt0, u / 60, u % 60, tile);
    else if (u < 1216) { int v = u - 960; wtrans_tile(p.w_out0, DM, p.wto0, v / 16, v % 16, tile); }
    else if (u < 2048) { int v = u - 1216; wtrans_tile(p.w_in1, N1, p.wt1, v / 52, v % 52, tile); }
    else { int v = u - 2048; wtrans_tile(p.w_out1, DM, p.wto1, v / 16, v % 16, tile); }
  }
}

namespace pg8 {
#define PG8_LAS __attribute__((address_space(3)))
constexpr int BM = 256, BK = 64, HALF = 128, HTB = HALF * BK * 2, NXCD = 8, WGM = 8;
__device__ __forceinline__ int lds_byte(int r, int c) { const int st = (r >> 4) * 2 + (c >> 5), rr = r & 15, cc = c & 31, ob = rr * 64 + cc * 2; return st * 1024 + (ob ^ (((ob >> 9) & 1) << 5)); }
__device__ __forceinline__ void stage_rc(int b, int& R, int& C) { const int st = b / 1024, sb = b % 1024, swz = sb ^ (((sb >> 9) & 1) << 5); R = (st >> 1) * 16 + swz / 64; C = (st & 1) * 32 + (swz % 64) / 2; }
__device__ __forceinline__ int perm32(int rho) { const int n = rho >> 4, i = rho & 15; return 8 * (i >> 2) + 4 * n + (i & 3); }
struct Unit { int pm, pn; };
struct Gemm { const bf16_t* A; const bf16_t* Bt; int M, N, K; };
struct StaticOrder {
  int nM, nN, nwg, G, c;
  __device__ void init(int M, int N, int G_, int c_) { nM = M / BM; nN = N / BM; nwg = nM * nN; G = G_; c = c_; }
  __device__ bool next(int i, Unit& u) const {
    const long L = (long)i * G + c; if (L >= nwg) return false;
    int wgid = (int)L; { const int q = nwg / NXCD, r = nwg % NXCD, xcd = wgid % NXCD, off = wgid / NXCD; wgid = (xcd < r ? xcd * (q + 1) : r * (q + 1) + (xcd - r) * q) + off; }
    const int nig = WGM * nN, gid = wgid / nig, fm = gid * WGM, gsz = (nM - fm) < WGM ? (nM - fm) : WGM;
    u.pm = fm + ((wgid % nig) % gsz); u.pn = (wgid % nig) / gsz; return true;
  }
};
struct EpiBf16 {
  static constexpr bool PERM = true;
  bf16_t* O; int ldc;
  __device__ __forceinline__ void operator()(const f32x4 (&acc)[2][2][4][2], const Unit& u, int wr, int wc, int fr, int fq) const {
    const int row0 = u.pm * BM + wr * 64 + fr, col0 = u.pn * BM + wc * 32 + 8 * fq;
#pragma unroll
    for (int ai = 0; ai < 2; ++ai)
#pragma unroll
      for (int m = 0; m < 4; ++m) {
        bf16_t* rowp = O + (size_t)(row0 + ai * HALF + m * 16) * ldc + col0;
#pragma unroll
        for (int bj = 0; bj < 2; ++bj) {
          const f32x4 v0 = acc[ai][bj][m][0], v1 = acc[ai][bj][m][1];
          uint4 o; o.x = pk_bf16(v0[0], v0[1]); o.y = pk_bf16(v0[2], v0[3]); o.z = pk_bf16(v1[0], v1[1]); o.w = pk_bf16(v1[2], v1[3]);
          *(uint4*)(rowp + bj * HALF) = o;
        }
      }
  }
};
struct EpiRes {
  static constexpr bool PERM = false;
  const float* X; float* Y;
  __device__ __forceinline__ void operator()(const f32x4 (&acc)[2][2][4][2], const Unit& u, int wr, int wc, int fr, int fq) const {
    const int row0 = u.pm * BM + wr * 64 + fr, col0 = u.pn * BM + wc * 32 + 4 * fq;
#pragma unroll
    for (int ai = 0; ai < 2; ++ai)
#pragma unroll
      for (int m = 0; m < 4; ++m) {
        const size_t ro = (size_t)(row0 + ai * HALF + m * 16) * DM + col0;
#pragma unroll
        for (int bj = 0; bj < 2; ++bj)
#pragma unroll
          for (int n = 0; n < 2; ++n) {
            const f32x4 xr = *(const f32x4*)(X + ro + bj * HALF + n * 16);
            *(f32x4*)(Y + ro + bj * HALF + n * 16) = xr * ALPHA + acc[ai][bj][m][n];
          }
      }
  }
};

template <class Epi>
__device__ __forceinline__ void gemm_phase(PG8_LAS unsigned char* lds, const Gemm g, const StaticOrder& S, const Epi& E) {
  const int tid = threadIdx.x, wid = __builtin_amdgcn_readfirstlane(tid >> 6), lane = tid & 63, wr = wid >> 2, wc = wid & 3, fr = lane & 15, fq = lane >> 4;
  const int K = g.K, nt = K / BK;
  unsigned voffA[2], voffB[2];
#pragma unroll
  for (int i = 0; i < 2; ++i) { int R, C; stage_rc(tid * 16 + i * 8192, R, C); const int Rb = Epi::PERM ? ((R & ~31) + perm32(R & 31)) : R;
    voffA[i] = (unsigned)(R * K + C) * 2u; voffB[i] = (unsigned)(Rb * K + C) * 2u; }
  const size_t kstep = (size_t)(BK * 2);
  const size_t hstep = (size_t)HALF * K * 2;
  const size_t tstep = 2 * hstep;
  const unsigned ldsw = (unsigned)wid * 1024u;
  const int aoff = lds_byte(wr * 64 + fr, fq * 8), boff = lds_byte(wc * 32 + fr, fq * 8);
#define PG8_SA(b, h) (((b) * 2 + (h)) * HTB)
#define PG8_SB(b, h) ((4 + (b) * 2 + (h)) * HTB)
#define PG8_STAGE(bufoff, gbase, voff) do { _Pragma("unroll") for (int _i = 0; _i < 2; ++_i) \
    __builtin_amdgcn_global_load_lds((const unsigned*)((const char*)(gbase) + (voff)[_i]), (PG8_LAS unsigned*)(lds + (bufoff) + ldsw + _i * 8192), 16, 0, 0); } while (0)
#define PG8_LDA(dst, b, h) do { _Pragma("unroll") for (int m = 0; m < 4; ++m) _Pragma("unroll") for (int k = 0; k < 2; ++k) dst[m][k] = *(const PG8_LAS bf16x8*)(lds + PG8_SA(b, h) + aoff + m * 2048 + k * 1024); } while (0)
#define PG8_LDB(dst, b, h) do { _Pragma("unroll") for (int n = 0; n < 2; ++n) _Pragma("unroll") for (int k = 0; k < 2; ++k) dst[n][k] = *(const PG8_LAS bf16x8*)(lds + PG8_SB(b, h) + boff + n * 2048 + k * 1024); } while (0)
#define PG8_MMA(ai, bj, At, Bt) do { __builtin_amdgcn_s_setprio(1); _Pragma("unroll") for (int m = 0; m < 4; ++m) _Pragma("unroll") for (int n = 0; n < 2; ++n) _Pragma("unroll") for (int k = 0; k < 2; ++k) \
    acc[ai][bj][m][n] = __builtin_amdgcn_mfma_f32_16x16x32_bf16(Bt[n][k], At[m][k], acc[ai][bj][m][n], 0, 0, 0); __builtin_amdgcn_s_setprio(0); } while (0)
#define PG8_WAIT_V(n) asm volatile("s_waitcnt vmcnt(" #n ")" ::: "memory")
#define PG8_WAIT_L(n) asm volatile("s_waitcnt lgkmcnt(" #n ")" ::: "memory")
#define PG8_BAR __builtin_amdgcn_s_barrier()
#define PG8_SCHED __builtin_amdgcn_sched_barrier(0)
  Unit cur, nxt; int ui = 0;
  if (!S.next(0, cur)) return;
  f32x4 acc[2][2][4][2];
#pragma unroll
  for (int a = 0; a < 2; ++a)
#pragma unroll
    for (int b = 0; b < 2; ++b)
#pragma unroll
      for (int m = 0; m < 4; ++m)
#pragma unroll
        for (int n = 0; n < 2; ++n) acc[a][b][m][n] = (f32x4){0.f, 0.f, 0.f, 0.f};
  bf16x8 At[4][2], B0[2][2], B1[2][2];
  const char* cA = (const char*)g.A + (size_t)cur.pm * tstep; const char* cB = (const char*)g.Bt + (size_t)cur.pn * tstep;
  PG8_STAGE(PG8_SB(0, 0), cB, voffB); PG8_STAGE(PG8_SA(0, 0), cA, voffA); PG8_STAGE(PG8_SB(0, 1), cB + hstep, voffB); PG8_STAGE(PG8_SA(0, 1), cA + hstep, voffA);
  if (wr == 1) PG8_BAR;
  PG8_WAIT_V(4); PG8_BAR;
  PG8_STAGE(PG8_SB(1, 0), cB + kstep, voffB); PG8_STAGE(PG8_SA(1, 0), cA + kstep, voffA); PG8_STAGE(PG8_SB(1, 1), cB + hstep + kstep, voffB);
  PG8_WAIT_V(6); PG8_BAR;
  for (;;) {
    const bool has_next = S.next(ui + 1, nxt);
    const char* nA = has_next ? (const char*)g.A + (size_t)nxt.pm * tstep : cA; const char* nB = has_next ? (const char*)g.Bt + (size_t)nxt.pn * tstep : cB;
    for (int t = 0; t < nt; t += 2) {
      const bool last = (t == nt - 2);
      const char* a1 = cA + (size_t)(t + 1) * kstep;
      const char* a2 = last ? nA : cA + (size_t)(t + 2) * kstep; const char* b2 = last ? nB : cB + (size_t)(t + 2) * kstep;
      const char* a3 = a2 + kstep; const char* b3 = b2 + kstep;
      PG8_LDB(B0, 0, 0); PG8_SCHED; PG8_LDA(At, 0, 0); PG8_STAGE(PG8_SA(1, 1), a1 + hstep, voffA);
      PG8_WAIT_L(8); PG8_BAR; PG8_WAIT_L(0); PG8_MMA(0, 0, At, B0); PG8_BAR; PG8_SCHED;
      PG8_LDB(B1, 0, 1); PG8_STAGE(PG8_SB(0, 0), b2, voffB);
      PG8_BAR; PG8_WAIT_L(0); PG8_MMA(0, 1, At, B1); PG8_BAR;
      PG8_LDA(At, 0, 1); PG8_STAGE(PG8_SA(0, 0), a2, voffA);
      PG8_BAR; PG8_WAIT_L(0); PG8_MMA(1, 0, At, B0); PG8_BAR; PG8_SCHED;
      PG8_STAGE(PG8_SB(0, 1), b2 + hstep, voffB);
      PG8_WAIT_V(6); PG8_BAR; PG8_MMA(1, 1, At, B1); PG8_BAR;
      PG8_LDB(B0, 1, 0); PG8_SCHED; PG8_LDA(At, 1, 0); PG8_STAGE(PG8_SA(0, 1), a2 + hstep, voffA);
      PG8_WAIT_L(8); PG8_BAR; PG8_WAIT_L(0); PG8_MMA(0, 0, At, B0); PG8_BAR; PG8_SCHED;
      PG8_LDB(B1, 1, 1); PG8_STAGE(PG8_SB(1, 0), b3, voffB);
      PG8_BAR; PG8_WAIT_L(0); PG8_MMA(0, 1, At, B1); PG8_BAR;
      PG8_LDA(At, 1, 1); PG8_STAGE(PG8_SA(1, 0), a3, voffA);
      PG8_BAR; PG8_WAIT_L(0); PG8_MMA(1, 0, At, B0); PG8_BAR; PG8_SCHED;
      PG8_STAGE(PG8_SB(1, 1), b3 + hstep, voffB);
      PG8_WAIT_V(6); PG8_BAR; PG8_MMA(1, 1, At, B1); PG8_BAR;
    }
    E(acc, cur, wr, wc, fr, fq);
    if (!has_next) break;
#pragma unroll
    for (int a = 0; a < 2; ++a)
#pragma unroll
      for (int b = 0; b < 2; ++b)
#pragma unroll
        for (int m = 0; m < 4; ++m)
#pragma unroll
          for (int n = 0; n < 2; ++n) acc[a][b][m][n] = (f32x4){0.f, 0.f, 0.f, 0.f};
    cur = nxt; cA = nA; cB = nB; ++ui;
  }
  PG8_WAIT_V(0);
  if (wr == 0) PG8_BAR;
  PG8_BAR;
#undef PG8_SA
#undef PG8_SB
#undef PG8_STAGE
#undef PG8_LDA
#undef PG8_LDB
#undef PG8_MMA
#undef PG8_WAIT_V
#undef PG8_WAIT_L
#undef PG8_BAR
#undef PG8_SCHED
}
}

template <class Epi>
__device__ __forceinline__ void gemm_run(const bf16_t* A, const bf16_t* Bt, int N, const Epi& E, char* smem) {
  pg8::Gemm g; g.A = A; g.Bt = Bt; g.M = NTOK; g.N = N; g.K = DM;
  pg8::StaticOrder S; S.init(NTOK, N, (int)gridDim.x, (int)blockIdx.x);
  pg8::gemm_phase<Epi>((PG8_LAS unsigned char*)smem, g, S, E);
  __syncthreads();
}

__device__ __forceinline__ void phase_conv(const Params& p, char* smem) {
  float* u = (float*)smem;
  const int tid = threadIdx.x, lane = tid & 63, wid = tid >> 6;
  const int c = tid;
  float w[31];
#pragma unroll
  for (int j = 0; j < 31; ++j) w[j] = p.conv_w[j * 512 + c];
  const float bias = p.conv_b[c];
  const int c8 = lane * 8;
  for (int tile = blockIdx.x; tile < 1024; tile += gridDim.x) {
    const int b = tile >> 6, t0 = (tile & 63) * 32;
#pragma unroll
    for (int it = 0; it < 8; ++it) {
      const int tt = wid + 8 * it;
      if (tt < 62) {
        const int t = t0 - 15 + tt;
        f32x4 u0 = (f32x4){0.f, 0.f, 0.f, 0.f}, u1 = (f32x4){0.f, 0.f, 0.f, 0.f};
        if (t >= 0 && t < T_) {
          const bf16_t* row = p.proj + (size_t)(b * T_ + t) * N0P;
          const uint4 v4 = *(const uint4*)(row + c8), g4 = *(const uint4*)(row + 512 + c8);
          const unsigned vw[4] = {v4.x, v4.y, v4.z, v4.w}, gw[4] = {g4.x, g4.y, g4.z, g4.w};
          float uu[8];
#pragma unroll
          for (int j = 0; j < 4; ++j) {
            uu[2 * j] = __uint_as_float(vw[j] << 16) * sigmoidf_(__uint_as_float(gw[j] << 16));
            uu[2 * j + 1] = __uint_as_float(vw[j] & 0xffff0000u) * sigmoidf_(__uint_as_float(gw[j] & 0xffff0000u));
          }
          u0 = (f32x4){uu[0], uu[1], uu[2], uu[3]}; u1 = (f32x4){uu[4], uu[5], uu[6], uu[7]};
        }
        *(f32x4*)(u + tt * 512 + c8) = u0; *(f32x4*)(u + tt * 512 + c8 + 4) = u1;
      }
    }
    __syncthreads();
    {
      float uin[47];
#pragma unroll
      for (int hh = 0; hh < 2; ++hh) {
#pragma unroll
        for (int r = 0; r < 46; ++r) uin[r] = u[(hh * 16 + r) * 512 + c];
        float accs[16];
#pragma unroll
        for (int ti = 0; ti < 16; ++ti) {
          float acc = bias;
#pragma unroll
          for (int j = 0; j < 31; ++j) acc += w[j] * uin[ti + j];
          accs[ti] = acc;
        }
        __syncthreads();
#pragma unroll
        for (int ti = 0; ti < 16; ++ti) u[(hh * 16 + ti) * 512 + c] = accs[ti];
      }
    }
    __syncthreads();
#pragma unroll 2
    for (int ti = wid; ti < 32; ti += 8) {
      const size_t tok = (size_t)b * T_ + t0 + ti;
      const uint4 g4 = *(const uint4*)(p.proj + tok * N0P + 1024 + c8);
      const f32x4 a0 = *(const f32x4*)(u + ti * 512 + c8), a1 = *(const f32x4*)(u + ti * 512 + c8 + 4);
      float v[8] = {a0[0], a0[1], a0[2], a0[3], a1[0], a1[1], a1[2], a1[3]};
      float s = 0.f;
#pragma unroll
      for (int i = 0; i < 8; ++i) s += v[i];
      const float mean = wave_sum(s) * (1.f / 512.f);
      float q = 0.f;
#pragma unroll
      for (int i = 0; i < 8; ++i) { v[i] -= mean; q += v[i] * v[i]; }
      const float rstd = rsqrtf(wave_sum(q) * (1.f / 512.f) + 1e-5f);
      const f32x4 lg0 = *(const f32x4*)(p.conv_ln_g + c8), lg1 = *(const f32x4*)(p.conv_ln_g + c8 + 4);
      const f32x4 lb0 = *(const f32x4*)(p.conv_ln_b + c8), lb1 = *(const f32x4*)(p.conv_ln_b + c8 + 4);
      const unsigned gw[4] = {g4.x, g4.y, g4.z, g4.w};
      unsigned ow[4];
#pragma unroll
      for (int j = 0; j < 4; ++j) {
        const float lga = (j < 2) ? lg0[2 * j] : lg1[2 * j - 4], lgb = (j < 2) ? lg0[2 * j + 1] : lg1[2 * j - 3];
        const float lba = (j < 2) ? lb0[2 * j] : lb1[2 * j - 4], lbb = (j < 2) ? lb0[2 * j + 1] : lb1[2 * j - 3];
        float ya = siluf_(v[2 * j] * rstd * lga + lba), yb = siluf_(v[2 * j + 1] * rstd * lgb + lbb);
        ya *= siluf_(__uint_as_float(gw[j] << 16)); yb *= siluf_(__uint_as_float(gw[j] & 0xffff0000u));
        ow[j] = pk_bf16(ya, yb);
      }
      *(uint4*)(p.ycat + tok * DM + c8) = make_uint4(ow[0], ow[1], ow[2], ow[3]);
    }
    __syncthreads();
  }
}

__device__ __forceinline__ void phase_scan(const Params& p, char* smem) {
  bf16_t* WupT = (bf16_t*)smem;
  bf16_t* AupT = (bf16_t*)(smem + 9216);
  float* MU = (float*)(smem + 14336);
  bf16_t* SB = (bf16_t*)(smem + 15488);
  bf16_t* TW = (bf16_t*)(smem + 24704);
  bf16_t* AL = (bf16_t*)(smem + 29312);
  float* WP = (float*)(smem + 31872);
  float* AP = (float*)(smem + 40064);
  float* GT = (float*)(smem + 131200);
  float* GC = (float*)(smem + 133248);
  float* KKv = (float*)(smem + 48256); float* Bv = KKv + 2048; float* KMv = Bv + 2048; float* LWv = KMv + 2048;
  float* Rv = LWv + 2048; float* Vv = Rv + 2048;
  bf16_t* MAK = (bf16_t*)(smem + 48256);
  bf16_t* MRB = (bf16_t*)(smem + 50816);
  bf16_t* MRK = (bf16_t*)(smem + 53376);
  float* MAB = (float*)(smem + 55936);
  float* Wb = (float*)(smem + 60544);
  bf16_t* UT = (bf16_t*)(smem + 69248);
  bf16_t* RAW = (bf16_t*)(smem + 97408);
  bf16_t* AH = (bf16_t*)(smem + 97408);
  bf16_t* BH = (bf16_t*)(smem + 102016);
  bf16_t* KH = (bf16_t*)(smem + 106624);
  bf16_t* RH = (bf16_t*)(smem + 111232);
  bf16_t* BTT = (bf16_t*)(smem + 115840);
  bf16_t* KTT = (bf16_t*)(smem + 120960);
  bf16_t* VT = (bf16_t*)(smem + 126080);
  const int tid = threadIdx.x, lane = tid & 63, wid = tid >> 6;
  const int fr = lane & 15, fq = lane >> 4;
  for (int seq = blockIdx.x; seq < 256; seq += gridDim.x) {
    const int d = seq >> 7, b = (seq >> 3) & 15, h = seq & 7;
    __syncthreads();
    if (tid < 288) MU[tid] = (tid < 192) ? p.mu[(tid >> 6) * 512 + h * 64 + (tid & 63)] : p.mu[1536 + d * 96 + (tid - 192)];
#pragma unroll
    for (int i = 0; i < 8; ++i) { const int e = tid + 512 * i; const int j = e >> 6, c = e & 63; WupT[c * 72 + j] = f2bf(p.w_up[((size_t)d * 64 + j) * 512 + h * 64 + c]); }
#pragma unroll
    for (int i = 0; i < 4; ++i) { const int e = tid + 512 * i; const int j = e >> 6, c = e & 63; AupT[c * 40 + j] = f2bf(p.a_up[((size_t)d * 32 + j) * 512 + h * 64 + c]); }
    const int ptok = tid >> 4, pc4 = (tid & 15) * 4;
    float w0v[4], a0v[4], kkc[4], kac[4], rkc[4];
#pragma unroll
    for (int i = 0; i < 4; ++i) {
      const int ch = h * 64 + pc4 + i;
      w0v[i] = p.w0[d * 512 + ch]; a0v[i] = p.a0[d * 512 + ch]; kkc[i] = p.k_k[ch]; kac[i] = p.k_a[ch]; rkc[i] = p.r_k[ch];
    }
    f32x4 accS[2];
    accS[0] = (f32x4){0.f, 0.f, 0.f, 0.f}; accS[1] = (f32x4){0.f, 0.f, 0.f, 0.f};
    for (int i = tid; i < 64 * 72 / 2; i += NTHR) ((unsigned*)SB)[i] = 0u;
    const bf16_t* pbase = p.proj + (size_t)b * T_ * N0P;
    uint4 pc0, pp0, pn0, pc1, pp1, pn1, pc2, pp2, pn2;
#define SCAN_LD(PC, PP, PN, TOK, CK, CI) do { \
      const int s_ = (CI) * 32 + (TOK); const int t_ = d ? (T_ - 1 - s_) : s_; \
      const int col_ = ((CK) < 24) ? (1536 + ((CK) >> 3) * 512 + h * 64 + ((CK) & 7) * 8) : (3072 + d * 96 + ((CK) - 24) * 8); \
      const bf16_t* g_ = pbase + (size_t)t_ * N0P + col_; \
      PC = *(const uint4*)g_; PP = make_uint4(0u, 0u, 0u, 0u); PN = make_uint4(0u, 0u, 0u, 0u); \
      if (t_ > 0) PP = *(const uint4*)(g_ - N0P); \
      if (t_ < T_ - 1) PN = *(const uint4*)(g_ + N0P); } while (0)
#define SCAN_ITEMS(TID) \
      const int tokA = (TID) / 24, ckA = (TID) - tokA * 24; \
      const int tokB = ((TID) + 512) / 24, ckB = ((TID) + 512) - tokB * 24; \
      const int tokC = (wid < 4) ? ((TID) >> 3) : (((TID) - 256) >> 2), ckC = (wid < 4) ? (24 + ((TID) & 7)) : (32 + (((TID) - 256) & 3));
#define SCAN_LOAD_ALL(CI) do { \
      SCAN_LD(pc0, pp0, pn0, tokA, ckA, CI); \
      if (wid < 4) SCAN_LD(pc1, pp1, pn1, tokB, ckB, CI); \
      if (wid < 6) SCAN_LD(pc2, pp2, pn2, tokC, ckC, CI); } while (0)
    {
      SCAN_ITEMS((int)threadIdx.x)
      pc1 = pp1 = pn1 = pc2 = pp2 = pn2 = make_uint4(0u, 0u, 0u, 0u);
      SCAN_LOAD_ALL(0);
    }
    for (int ci = 0; ci < 64; ++ci) {
      int lz = 0; asm volatile("" : "+v"(lz));
      const int tid = (int)threadIdx.x + lz, lane = tid & 63, fr = lane & 15, fq = lane >> 4, ptok = tid >> 4, pc4 = (tid & 15) * 4;
      SCAN_ITEMS(tid)
#define SHIFT8(ZC, ZP, ZN, CK, VAL) do { \
        const f32x4 m0 = *(const f32x4*)(MU + (CK) * 8), m1 = *(const f32x4*)(MU + (CK) * 8 + 4); \
        const unsigned zcw[4] = {ZC.x, ZC.y, ZC.z, ZC.w}, zpw[4] = {ZP.x, ZP.y, ZP.z, ZP.w}, znw[4] = {ZN.x, ZN.y, ZN.z, ZN.w}; \
        _Pragma("unroll") for (int j = 0; j < 4; ++j) { \
          const float c0 = __uint_as_float(zcw[j] << 16), c1 = __uint_as_float(zcw[j] & 0xffff0000u); \
          const float p0 = __uint_as_float(zpw[j] << 16), p1 = __uint_as_float(zpw[j] & 0xffff0000u); \
          const float n0 = __uint_as_float(znw[j] << 16), n1 = __uint_as_float(znw[j] & 0xffff0000u); \
          const float mm0 = (j < 2) ? m0[2 * j] : m1[2 * j - 4], mm1 = (j < 2) ? m0[2 * j + 1] : m1[2 * j - 3]; \
          VAL[2 * j] = c0 + mm0 * (0.5f * (p0 + n0) - c0); \
          VAL[2 * j + 1] = c1 + mm1 * (0.5f * (p1 + n1) - c1); } } while (0)
      {
        float val[8];
        SHIFT8(pc0, pp0, pn0, ckA, val);
        float* dst = (ckA < 8) ? Rv : ((ckA < 16) ? KMv : Vv);
        *(f32x4*)(dst + tokA * 64 + (ckA & 7) * 8) = (f32x4){val[0], val[1], val[2], val[3]};
        *(f32x4*)(dst + tokA * 64 + (ckA & 7) * 8 + 4) = (f32x4){val[4], val[5], val[6], val[7]};
      }
      if (wid < 4) {
        float val[8];
        SHIFT8(pc1, pp1, pn1, ckB, val);
        float* dst = (ckB < 8) ? Rv : ((ckB < 16) ? KMv : Vv);
        *(f32x4*)(dst + tokB * 64 + (ckB & 7) * 8) = (f32x4){val[0], val[1], val[2], val[3]};
        *(f32x4*)(dst + tokB * 64 + (ckB & 7) * 8 + 4) = (f32x4){val[4], val[5], val[6], val[7]};
      }
      if (wid < 4) {
        float val[8];
        SHIFT8(pc2, pp2, pn2, ckC, val);
        uint4 o; o.x = pk_bf16(tanhf_(val[0]), tanhf_(val[1])); o.y = pk_bf16(tanhf_(val[2]), tanhf_(val[3]));
        o.z = pk_bf16(tanhf_(val[4]), tanhf_(val[5])); o.w = pk_bf16(tanhf_(val[6]), tanhf_(val[7]));
        *(uint4*)(TW + tokC * 72 + (ckC - 24) * 8) = o;
      } else if (wid < 6) {
        float val[8];
        SHIFT8(pc2, pp2, pn2, ckC, val);
        uint4 o; o.x = pk_bf16(val[0], val[1]); o.y = pk_bf16(val[2], val[3]); o.z = pk_bf16(val[4], val[5]); o.w = pk_bf16(val[6], val[7]);
        *(uint4*)(AL + tokC * 40 + (ckC - 32) * 8) = o;
      }
#undef SHIFT8
      if (ci + 1 < 64) SCAN_LOAD_ALL(ci + 1);
      __syncthreads();
      {
        const int mt = wid >> 2, nt = wid & 3;
        f32x4 accw = (f32x4){0.f, 0.f, 0.f, 0.f}, acca = (f32x4){0.f, 0.f, 0.f, 0.f};
#pragma unroll
        for (int ks = 0; ks < 2; ++ks) {
          const bf16x8 a_op = *(const bf16x8*)(TW + (mt * 16 + fr) * 72 + ks * 32 + fq * 8);
          const bf16x8 b_op = *(const bf16x8*)(WupT + (nt * 16 + fr) * 72 + ks * 32 + fq * 8);
          accw = __builtin_amdgcn_mfma_f32_16x16x32_bf16(a_op, b_op, accw, 0, 0, 0);
        }
        {
          const bf16x8 a_op = *(const bf16x8*)(AL + (mt * 16 + fr) * 40 + fq * 8);
          const bf16x8 b_op = *(const bf16x8*)(AupT + (nt * 16 + fr) * 40 + fq * 8);
          acca = __builtin_amdgcn_mfma_f32_16x16x32_bf16(a_op, b_op, acca, 0, 0, 0);
        }
#pragma unroll
        for (int r = 0; r < 4; ++r) {
          WP[(mt * 16 + fq * 4 + r) * 64 + nt * 16 + fr] = accw[r];
          AP[(mt * 16 + fq * 4 + r) * 64 + nt * 16 + fr] = acca[r];
        }
      }
      __syncthreads();
      {
        const f32x4 wp = *(const f32x4*)(WP + ptok * 64 + pc4);
        const f32x4 ap = *(const f32x4*)(AP + ptok * 64 + pc4);
        const f32x4 kr = *(const f32x4*)(KMv + ptok * 64 + pc4);
        const f32x4 rv = *(const f32x4*)(Rv + ptok * 64 + pc4);
        f32x2 kkv[2], av[2], lwv[2], kmv[2];
        f32x2 ssq2 = (f32x2){0.f, 0.f}, bet2 = (f32x2){0.f, 0.f};
#pragma unroll
        for (int hp = 0; hp < 2; ++hp) {
          const f32x2 wx = (f32x2){w0v[2 * hp], w0v[2 * hp + 1]} + (f32x2){wp[2 * hp], wp[2 * hp + 1]};
          const f32x2 ax = (f32x2){a0v[2 * hp], a0v[2 * hp + 1]} + (f32x2){ap[2 * hp], ap[2 * hp + 1]};
          f32x2 sg, sa_;
          sg[0] = sigmoidf_(wx[0]); sg[1] = sigmoidf_(wx[1]);
          sa_[0] = sigmoidf_(ax[0]); sa_[1] = sigmoidf_(ax[1]);
          lwv[hp] = sg * (-0.60653065971f);
          av[hp] = sa_;
          const f32x2 k2 = (f32x2){kr[2 * hp], kr[2 * hp + 1]};
          kkv[hp] = k2 * (f32x2){kkc[2 * hp], kkc[2 * hp + 1]};
          ssq2 += kkv[hp] * kkv[hp];
          kmv[hp] = k2 * ((sa_ - 1.f) * (f32x2){kac[2 * hp], kac[2 * hp + 1]} + 1.f);
          bet2 += (f32x2){rv[2 * hp], rv[2 * hp + 1]} * kmv[hp] * (f32x2){rkc[2 * hp], rkc[2 * hp + 1]};
        }
        float ssq = ssq2[0] + ssq2[1], bet = bet2[0] + bet2[1];
        for (int m = 0; m < 1; ++m) {
          ssq += dppf<0xB1>(ssq); bet += dppf<0xB1>(bet);
          ssq += dppf<0x4E>(ssq); bet += dppf<0x4E>(bet);
          ssq += dppf<0x141>(ssq); bet += dppf<0x141>(bet);
          ssq += dppf<0x140>(ssq); bet += dppf<0x140>(bet);
        }
        const float rn = rsqrtf(ssq + 1e-12f);
        const f32x2 kk0 = kkv[0] * rn, kk1 = kkv[1] * rn;
        const f32x2 b0 = kk0 * av[0], b1 = kk1 * av[1];
        *(f32x4*)(KKv + ptok * 64 + pc4) = (f32x4){kk0[0], kk0[1], kk1[0], kk1[1]};
        *(f32x4*)(Bv + ptok * 64 + pc4) = (f32x4){b0[0], b0[1], b1[0], b1[1]};
        *(f32x4*)(KMv + ptok * 64 + pc4) = (f32x4){kmv[0][0], kmv[0][1], kmv[1][0], kmv[1][1]};
        *(f32x4*)(LWv + ptok * 64 + pc4) = (f32x4){lwv[0][0], lwv[0][1], lwv[1][0], lwv[1][1]};
        if ((tid & 15) == 0) {
          const int s = ci * 32 + ptok; const int t = d ? (T_ - 1 - s) : s;
          p.beta[(((size_t)d * NB_ + b) * T_ + t) * 8 + h] = bet;
        }
      }
      asm volatile("s_waitcnt lgkmcnt(0)" ::: "memory");
      __builtin_amdgcn_wave_barrier();
      {
        const int c = lane, tg = wid;
        float lw[4], cs[4];
#pragma unroll
        for (int j = 0; j < 4; ++j) lw[j] = LWv[(4 * tg + j) * 64 + c];
        cs[0] = lw[0]; cs[1] = cs[0] + lw[1]; cs[2] = cs[1] + lw[2]; cs[3] = cs[2] + lw[3];
        GT[tg * 64 + c] = cs[3];
        __syncthreads();
        float offs = 0.f, tot = 0.f;
#pragma unroll
        for (int g2 = 0; g2 < 8; ++g2) { const float gv = GT[g2 * 64 + c]; tot += gv; if (g2 < tg) offs += gv; }
        float bt4[4], kt4[4], vt4[4];
        const float etot = __expf(tot);
        float epv = __expf(offs);
#pragma unroll
        for (int j = 0; j < 4; ++j) {
          const int t = 4 * tg + j;
          const float lg = offs + cs[j];
          const float kap = KKv[t * 64 + c], bb = Bv[t * 64 + c], km = KMv[t * 64 + c], rr = Rv[t * 64 + c];
          vt4[j] = Vv[t * 64 + c];
          const float ep = __expf(lg), em = __builtin_amdgcn_rcpf(ep), ec = etot * em;
          AH[t * 72 + c] = f2bf(-kap * epv);
          BH[t * 72 + c] = f2bf(bb * em);
          KH[t * 72 + c] = f2bf(km * em);
          RH[t * 72 + c] = f2bf(rr * ep);
          bt4[j] = bb * ec; kt4[j] = km * ec;
          epv = ep;
        }
        *(uint2*)(BTT + c * 40 + 4 * tg) = make_uint2(pk_bf16(bt4[0], bt4[1]), pk_bf16(bt4[2], bt4[3]));
        *(uint2*)(KTT + c * 40 + 4 * tg) = make_uint2(pk_bf16(kt4[0], kt4[1]), pk_bf16(kt4[2], kt4[3]));
        *(uint2*)(VT + c * 40 + 4 * tg) = make_uint2(pk_bf16(vt4[0], vt4[1]), pk_bf16(vt4[2], vt4[3]));
        if (tg == 0) GC[c] = etot;
      }
      __syncthreads();
      {
        const int mtx = wid >> 1, it = wid & 1;
        const bf16_t* Pi = (mtx & 1) ? KH : BH;
        const bf16_t* Qt = (mtx < 2) ? AH : RH;
        const bf16x8 pa0 = *(const bf16x8*)(Pi + (it * 16 + fr) * 72 + fq * 8);
        const bf16x8 pa1 = *(const bf16x8*)(Pi + (it * 16 + fr) * 72 + 32 + fq * 8);
#pragma unroll
        for (int tt = 0; tt < 2; ++tt) {
          f32x4 acc = (f32x4){0.f, 0.f, 0.f, 0.f};
          const bf16x8 qb0 = *(const bf16x8*)(Qt + (tt * 16 + fr) * 72 + fq * 8);
          const bf16x8 qb1 = *(const bf16x8*)(Qt + (tt * 16 + fr) * 72 + 32 + fq * 8);
          acc = __builtin_amdgcn_mfma_f32_16x16x32_bf16(pa0, qb0, acc, 0, 0, 0);
          acc = __builtin_amdgcn_mfma_f32_16x16x32_bf16(pa1, qb1, acc, 0, 0, 0);
          const int t = tt * 16 + fr, i0 = it * 16 + fq * 4;
          const int lim = (mtx < 2) ? (t - 1) : t;
          f32x4 mk;
#pragma unroll
          for (int r = 0; r < 4; ++r) mk[r] = (i0 + r <= lim) ? acc[r] : 0.f;
          if (mtx == 0) {
#pragma unroll
            for (int r = 0; r < 4; ++r) { const int i = i0 + r; MAB[t * 32 + (i & 3) * 8 + (i >> 2)] = mk[r]; }
          }
          else {
            bf16_t* Mo = (mtx == 1) ? MAK : ((mtx == 2) ? MRB : MRK);
            *(uint2*)(Mo + t * 40 + i0) = make_uint2(pk_bf16(mk[0], mk[1]), pk_bf16(mk[2], mk[3]));
          }
        }
      }
      const int vt_ = wid >> 1, tt_ = wid & 1;
      f32x4 accY = (f32x4){0.f, 0.f, 0.f, 0.f}, accW = (f32x4){0.f, 0.f, 0.f, 0.f};
      {
        const bf16x8 s0 = *(const bf16x8*)(SB + (vt_ * 16 + fr) * 72 + fq * 8);
        const bf16x8 s1 = *(const bf16x8*)(SB + (vt_ * 16 + fr) * 72 + 32 + fq * 8);
        const bf16x8 a0 = *(const bf16x8*)(AH + (tt_ * 16 + fr) * 72 + fq * 8);
        const bf16x8 a1 = *(const bf16x8*)(AH + (tt_ * 16 + fr) * 72 + 32 + fq * 8);
        const bf16x8 r0 = *(const bf16x8*)(RH + (tt_ * 16 + fr) * 72 + fq * 8);
        const bf16x8 r1 = *(const bf16x8*)(RH + (tt_ * 16 + fr) * 72 + 32 + fq * 8);
        accW = __builtin_amdgcn_mfma_f32_16x16x32_bf16(s0, a0, accW, 0, 0, 0);
        accW = __builtin_amdgcn_mfma_f32_16x16x32_bf16(s1, a1, accW, 0, 0, 0);
        accY = __builtin_amdgcn_mfma_f32_16x16x32_bf16(s0, r0, accY, 0, 0, 0);
        accY = __builtin_amdgcn_mfma_f32_16x16x32_bf16(s1, r1, accY, 0, 0, 0);
      }
      __syncthreads();
      {
        const bf16x8 vv = *(const bf16x8*)(VT + (vt_ * 16 + fr) * 40 + fq * 8);
        const bf16x8 mak = *(const bf16x8*)(MAK + (tt_ * 16 + fr) * 40 + fq * 8);
        const bf16x8 mrk = *(const bf16x8*)(MRK + (tt_ * 16 + fr) * 40 + fq * 8);
        accW = __builtin_amdgcn_mfma_f32_16x16x32_bf16(vv, mak, accW, 0, 0, 0);
        accY = __builtin_amdgcn_mfma_f32_16x16x32_bf16(vv, mrk, accY, 0, 0, 0);
        *(f32x4*)(Wb + (tt_ * 16 + fr) * 68 + vt_ * 16 + fq * 4) = accW;
      }
      __syncthreads();
      if (wid < 4) {
        const int q = lane & 3, v = wid * 16 + (lane >> 2);
        f32x2 u01 = (f32x2){0.f, 0.f}, u23 = (f32x2){0.f, 0.f}, u45 = (f32x2){0.f, 0.f}, u67 = (f32x2){0.f, 0.f};
        f32x4 Am0[4], Am1[4], Bm0[4], Bm1[4]; float Aw[4], Bw[4];
#define P6_LOAD(X, T0) do { _Pragma("unroll") for (int s_ = 0; s_ < 4; ++s_) { const int t_ = (T0) + s_; \
          X##m0[s_] = *(const f32x4*)(MAB + t_ * 32 + q * 8); X##m1[s_] = *(const f32x4*)(MAB + t_ * 32 + q * 8 + 4); X##w[s_] = Wb[t_ * 68 + v]; } } while (0)
#define P6_STEPS(X, T0) do { _Pragma("unroll") for (int s_ = 0; s_ < 4; ++s_) { const int t_ = (T0) + s_; \
          f32x2 pa_ = u01 * (f32x2){X##m0[s_][0], X##m0[s_][1]} + u45 * (f32x2){X##m1[s_][0], X##m1[s_][1]}; \
          f32x2 pb_ = u23 * (f32x2){X##m0[s_][2], X##m0[s_][3]} + u67 * (f32x2){X##m1[s_][2], X##m1[s_][3]}; \
          pa_ += pb_; \
          float part = pa_[0] + pa_[1]; \
          part += dppf<0xB1>(part); part += dppf<0x4E>(part); \
          const float ut = X##w[s_] + part; \
          const bool mine = (q == (t_ & 3)); const int j_ = t_ >> 2; \
          if (j_ == 0) u01[0] = mine ? ut : u01[0]; else if (j_ == 1) u01[1] = mine ? ut : u01[1]; \
          else if (j_ == 2) u23[0] = mine ? ut : u23[0]; else if (j_ == 3) u23[1] = mine ? ut : u23[1]; \
          else if (j_ == 4) u45[0] = mine ? ut : u45[0]; else if (j_ == 5) u45[1] = mine ? ut : u45[1]; \
          else if (j_ == 6) u67[0] = mine ? ut : u67[0]; else u67[1] = mine ? ut : u67[1]; } } while (0)
        P6_LOAD(A, 0);
#pragma unroll
        for (int blk = 0; blk < 8; blk += 2) {
          P6_LOAD(B, (blk + 1) * 4);
          P6_STEPS(A, blk * 4);
          if (blk + 2 < 8) P6_LOAD(A, (blk + 2) * 4);
          P6_STEPS(B, (blk + 1) * 4);
        }
#undef P6_LOAD
#undef P6_STEPS
        bf16_t* up = UT + v * 40 + q;
        up[0] = f2bf(u01[0]); up[4] = f2bf(u01[1]); up[8] = f2bf(u23[0]); up[12] = f2bf(u23[1]);
        up[16] = f2bf(u45[0]); up[20] = f2bf(u45[1]); up[24] = f2bf(u67[0]); up[28] = f2bf(u67[1]);
      }
      __syncthreads();
      {
        const bf16x8 uu = *(const bf16x8*)(UT + (vt_ * 16 + fr) * 40 + fq * 8);
        const bf16x8 mrb = *(const bf16x8*)(MRB + (tt_ * 16 + fr) * 40 + fq * 8);
        accY = __builtin_amdgcn_mfma_f32_16x16x32_bf16(uu, mrb, accY, 0, 0, 0);
        const int s = ci * 32 + tt_ * 16 + fr; const int t = d ? (T_ - 1 - s) : s;
        *(uint2*)(p.ys + ((size_t)d * NTOK + (size_t)b * T_ + t) * 512 + h * 64 + vt_ * 16 + fq * 4) = make_uint2(pk_bf16(accY[0], accY[1]), pk_bf16(accY[2], accY[3]));
        const int kt_ = wid >> 1;
        const f32x4 gc = *(const f32x4*)(GC + kt_ * 16 + fq * 4);
        const bf16x8 bt = *(const bf16x8*)(BTT + (kt_ * 16 + fr) * 40 + fq * 8);
        const bf16x8 ktv = *(const bf16x8*)(KTT + (kt_ * 16 + fr) * 40 + fq * 8);
#pragma unroll
        for (int j = 0; j < 2; ++j) {
          const int v2 = (wid & 1) * 2 + j;
          const bf16x8 u2 = *(const bf16x8*)(UT + (v2 * 16 + fr) * 40 + fq * 8);
          const bf16x8 vv2 = *(const bf16x8*)(VT + (v2 * 16 + fr) * 40 + fq * 8);
          accS[j] = accS[j] * gc;
          accS[j] = __builtin_amdgcn_mfma_f32_16x16x32_bf16(bt, u2, accS[j], 0, 0, 0);
          accS[j] = __builtin_amdgcn_mfma_f32_16x16x32_bf16(ktv, vv2, accS[j], 0, 0, 0);
          *(uint2*)(SB + (v2 * 16 + fr) * 72 + kt_ * 16 + fq * 4) = make_uint2(pk_bf16(accS[j][0], accS[j][1]), pk_bf16(accS[j][2], accS[j][3]));
        }
      }
      __syncthreads();
    }
  }
#undef SCAN_LD
#undef SCAN_ITEMS
#undef SCAN_LOAD_ALL
}

__device__ __forceinline__ void phase_rwkv_fin(const Params& p) {
  const int lane = threadIdx.x & 63, wid = threadIdx.x >> 6;
  const int ch0 = lane * 8, h = lane >> 3;
  float gng[8], gnb[8], muv[8];
#pragma unroll
  for (int j = 0; j < 8; ++j) { gng[j] = p.gn_g[ch0 + j]; gnb[j] = p.gn_b[ch0 + j]; muv[j] = p.mu[1024 + ch0 + j]; }
  const int stride = gridDim.x * 8;
  for (int tok0 = blockIdx.x * 8 + wid; tok0 < NTOK; tok0 += 2 * stride) {
    f32x4 ya0[2], ya1[2], yb0[2], yb1[2]; uint4 zc4[2], zp4[2], zn4[2], g4[2]; float bet[2];
#pragma unroll
    for (int r = 0; r < 2; ++r) {
      const int tok = tok0 + r * stride;
      if (tok < NTOK) {
        const int b = tok >> 11, t = tok & 2047;
        {
          const uint4 qa = *(const uint4*)(p.ys + (size_t)tok * 512 + ch0), qb = *(const uint4*)(p.ys + ((size_t)NTOK + tok) * 512 + ch0);
          ya0[r] = (f32x4){__uint_as_float(qa.x << 16), __uint_as_float(qa.x & 0xffff0000u), __uint_as_float(qa.y << 16), __uint_as_float(qa.y & 0xffff0000u)};
          ya1[r] = (f32x4){__uint_as_float(qa.z << 16), __uint_as_float(qa.z & 0xffff0000u), __uint_as_float(qa.w << 16), __uint_as_float(qa.w & 0xffff0000u)};
          yb0[r] = (f32x4){__uint_as_float(qb.x << 16), __uint_as_float(qb.x & 0xffff0000u), __uint_as_float(qb.y << 16), __uint_as_float(qb.y & 0xffff0000u)};
          yb1[r] = (f32x4){__uint_as_float(qb.z << 16), __uint_as_float(qb.z & 0xffff0000u), __uint_as_float(qb.w << 16), __uint_as_float(qb.w & 0xffff0000u)};
        }
        const bf16_t* zp_ = p.proj + (size_t)tok * N0P + 2560 + ch0;
        zc4[r] = *(const uint4*)zp_;
        zp4[r] = make_uint4(0u, 0u, 0u, 0u); zn4[r] = make_uint4(0u, 0u, 0u, 0u);
        if (t > 0) zp4[r] = *(const uint4*)(zp_ - N0P);
        if (t < T_ - 1) zn4[r] = *(const uint4*)(zp_ + N0P);
        g4[r] = *(const uint4*)(p.proj + (size_t)tok * N0P + 3264 + ch0);
        bet[r] = 0.5f * (p.beta[((size_t)b * T_ + t) * 8 + h] + p.beta[(((size_t)NB_ + b) * T_ + t) * 8 + h]);
      }
    }
#pragma unroll
    for (int r = 0; r < 2; ++r) {
      const int tok = tok0 + r * stride;
      if (tok < NTOK) {
        float y[8];
#pragma unroll
        for (int j = 0; j < 4; ++j) { y[j] = ya0[r][j] + yb0[r][j]; y[4 + j] = ya1[r][j] + yb1[r][j]; }
        float sm = 0.f;
#pragma unroll
        for (int j = 0; j < 8; ++j) sm += y[j];
        sm += dppf0<0xB1>(sm); sm += dppf0<0x4E>(sm); sm += dppf0<0x141>(sm);
        const float mean = sm * (1.f / 64.f);
        float sq = 0.f;
#pragma unroll
        for (int j = 0; j < 8; ++j) { y[j] -= mean; sq += y[j] * y[j]; }
        sq += dppf0<0xB1>(sq); sq += dppf0<0x4E>(sq); sq += dppf0<0x141>(sq);
        const float rstd = rsqrtf(sq * (1.f / 64.f) + 64e-5f);
        const unsigned zcw[4] = {zc4[r].x, zc4[r].y, zc4[r].z, zc4[r].w}, zpw[4] = {zp4[r].x, zp4[r].y, zp4[r].z, zp4[r].w};
        const unsigned znw[4] = {zn4[r].x, zn4[r].y, zn4[r].z, zn4[r].w}, gw[4] = {g4[r].x, g4[r].y, g4[r].z, g4[r].w};
        float o[8];
#pragma unroll
        for (int j = 0; j < 4; ++j) {
#pragma unroll
          for (int e = 0; e < 2; ++e) {
            const int jj = 2 * j + e;
            const float zc = e ? __uint_as_float(zcw[j] & 0xffff0000u) : __uint_as_float(zcw[j] << 16);
            const float zp = e ? __uint_as_float(zpw[j] & 0xffff0000u) : __uint_as_float(zpw[j] << 16);
            const float zn = e ? __uint_as_float(znw[j] & 0xffff0000u) : __uint_as_float(znw[j] << 16);
            const float g = e ? __uint_as_float(gw[j] & 0xffff0000u) : __uint_as_float(gw[j] << 16);
            const float vs = zc + muv[jj] * (0.5f * (zp + zn) - zc);
            const float yn = y[jj] * rstd * gng[jj] + gnb[jj];
            o[jj] = (yn + bet[r] * vs) * siluf_(g);
          }
        }
        *(uint4*)(p.ycat + (size_t)tok * DM + 512 + ch0) = make_uint4(pk_bf16(o[0], o[1]), pk_bf16(o[2], o[3]), pk_bf16(o[4], o[5]), pk_bf16(o[6], o[7]));
      }
    }
  }
}

template <bool XBF>
__device__ __forceinline__ void phase_ln(const void* xin_, const bf16_t* hb, float* yout, const float* __restrict__ g, const float* __restrict__ bb, bf16_t* ob) {
  const float* xin = (const float*)xin_; const bf16_t* xinb = (const bf16_t*)xin_;
  const int lane = threadIdx.x & 63, wid = threadIdx.x >> 6;
  const int stride = gridDim.x * 8;
  f32x4 gg[4], b4[4];
#pragma unroll
  for (int i = 0; i < 2; ++i) { const int c = lane * 8 + 512 * i; gg[2 * i] = *(const f32x4*)(g + c); gg[2 * i + 1] = *(const f32x4*)(g + c + 4); b4[2 * i] = *(const f32x4*)(bb + c); b4[2 * i + 1] = *(const f32x4*)(bb + c + 4); }
  for (int row0 = blockIdx.x * 8 + wid; row0 < NTOK; row0 += 2 * stride) {
    f32x4 xv[2][4]; uint4 hv[2][2];
#pragma unroll
    for (int r = 0; r < 2; ++r) {
      const int row = row0 + r * stride;
      if (row < NTOK) {
#pragma unroll
        for (int i = 0; i < 2; ++i) {
          const int c = lane * 8 + 512 * i;
          if (XBF) {
            const uint4 xq = *(const uint4*)(xinb + (size_t)row * DM + c);
            xv[r][2 * i] = (f32x4){__uint_as_float(xq.x << 16), __uint_as_float(xq.x & 0xffff0000u), __uint_as_float(xq.y << 16), __uint_as_float(xq.y & 0xffff0000u)};
            xv[r][2 * i + 1] = (f32x4){__uint_as_float(xq.z << 16), __uint_as_float(xq.z & 0xffff0000u), __uint_as_float(xq.w << 16), __uint_as_float(xq.w & 0xffff0000u)};
          } else {
            xv[r][2 * i] = *(const f32x4*)(xin + (size_t)row * DM + c); xv[r][2 * i + 1] = *(const f32x4*)(xin + (size_t)row * DM + c + 4);
          }
          hv[r][i] = *(const uint4*)(hb + (size_t)row * DM + c);
        }
      }
    }
#pragma unroll
    for (int r = 0; r < 2; ++r) {
      const int row = row0 + r * stride;
      if (row < NTOK) {
        float v[16]; float s = 0.f;
#pragma unroll
        for (int i = 0; i < 2; ++i) {
          const unsigned hw[4] = {hv[r][i].x, hv[r][i].y, hv[r][i].z, hv[r][i].w};
#pragma unroll
          for (int j = 0; j < 4; ++j) {
            const float xa = (j < 2) ? xv[r][2 * i][2 * j] : xv[r][2 * i + 1][2 * j - 4], xb2 = (j < 2) ? xv[r][2 * i][2 * j + 1] : xv[r][2 * i + 1][2 * j - 3];
            v[8 * i + 2 * j] = ALPHA * xa + __uint_as_float(hw[j] << 16);
            v[8 * i + 2 * j + 1] = ALPHA * xb2 + __uint_as_float(hw[j] & 0xffff0000u);
            s += v[8 * i + 2 * j] + v[8 * i + 2 * j + 1];
          }
        }
        const float mean = wave_sum(s) * (1.f / 1024.f);
        float q = 0.f;
#pragma unroll
        for (int i = 0; i < 16; ++i) { v[i] -= mean; q += v[i] * v[i]; }
        const float rstd = rsqrtf(wave_sum(q) * (1.f / 1024.f) + 1e-5f);
#pragma unroll
        for (int i = 0; i < 2; ++i) {
          const int c = lane * 8 + 512 * i;
          f32x4 o0, o1;
#pragma unroll
          for (int j = 0; j < 4; ++j) { o0[j] = v[8 * i + j] * rstd * gg[2 * i][j] + b4[2 * i][j]; o1[j] = v[8 * i + 4 + j] * rstd * gg[2 * i + 1][j] + b4[2 * i + 1][j]; }
          if (yout) { *(f32x4*)(yout + (size_t)row * DM + c) = o0; *(f32x4*)(yout + (size_t)row * DM + c + 4) = o1; }
          if (ob) *(uint4*)(ob + (size_t)row * DM + c) = make_uint4(pk_bf16(o0[0], o0[1]), pk_bf16(o0[2], o0[3]), pk_bf16(o1[0], o1[1]), pk_bf16(o1[2], o1[3]));
        }
      }
    }
  }
}

__device__ __forceinline__ int swz64(int row, int ch) { return row * 64 + ((ch ^ ((row >> 1) & 7)) << 3); }

__device__ __forceinline__ void phase_gla(const Params& p, char* smem) {
  bf16_t* QT = (bf16_t*)smem;
  bf16_t* KT = QT + 64 * 136;
  bf16_t* KRT = KT + 64 * 136;
  bf16_t* VT = KRT + 128 * 72;
  bf16_t* PP = VT + 128 * 72;
  bf16_t* ST = PP + 64 * 72;
  float* LR = (float*)(ST + 128 * 136);
  float* GT = LR + 1024;
  float* DEC = GT + 1024;
  float* LR1 = DEC + 128;
  const int tid = threadIdx.x, lane = tid & 63, wid = tid >> 6;
  const int fr = lane & 15, fq = lane >> 4;
  const int c2 = tid & 63, tg = tid >> 6;
  for (int item = blockIdx.x; item < 256; item += gridDim.x) {
    const int d = item >> 7, b = (item >> 3) & 15, h = (item >> 1) & 3, vh = item & 1;
    __syncthreads();
    for (int i = tid; i < 128 * 136 / 2; i += NTHR) ((unsigned*)ST)[i] = 0u;
    f32x2 gup2[16];
#pragma unroll
    for (int r = 0; r < 16; ++r) gup2[r] = *(const f32x2*)(p.g_up + ((size_t)d * 16 + r) * 512 + h * 128 + 2 * c2);
    const f32x2 gb2 = *(const f32x2*)(p.g_bias + d * 512 + h * 128 + 2 * c2);
    f32x4 accs[8];
#pragma unroll
    for (int i = 0; i < 8; ++i) accs[i] = (f32x4){0.f, 0.f, 0.f, 0.f};
    const bf16_t* pbase = p.proj + (size_t)b * T_ * N1P;
    bf16_t lrr[2]; unsigned qr[8], kr[8], vr[8];
#define GLA_LOAD_RAW(CI) do { \
      _Pragma("unroll") for (int i2_ = 0; i2_ < 2; ++i2_) { \
        const int e_ = tid + 512 * i2_; const int tok_ = e_ >> 4, r_ = e_ & 15; \
        const int s_ = (CI) * 64 + tok_; const int t_ = d ? (T_ - 1 - s_) : s_; \
        lrr[i2_] = pbase[(size_t)t_ * N1P + 3072 + d * 16 + r_]; } \
      _Pragma("unroll") for (int ii_ = 0; ii_ < 8; ++ii_) { \
        const int s_ = (CI) * 64 + tg * 8 + ii_; const int t_ = d ? (T_ - 1 - s_) : s_; \
        const bf16_t* rowp_ = pbase + (size_t)t_ * N1P; \
        qr[ii_] = *(const unsigned*)(rowp_ + h * 128 + 2 * c2); kr[ii_] = *(const unsigned*)(rowp_ + 512 + h * 128 + 2 * c2); \
        vr[ii_] = *(const unsigned*)(rowp_ + 1024 + h * 256 + vh * 128 + 2 * c2); } } while (0)
    GLA_LOAD_RAW(0);
    for (int ci = 0; ci < 32; ++ci) {
#pragma unroll
      for (int i2 = 0; i2 < 2; ++i2) { const int e = tid + 512 * i2; LR[(e >> 4) * 16 + (e & 15)] = bf2f(lrr[i2]); }
      __syncthreads();
      f32x2 bl[8]; f32x2 cum = (f32x2){0.f, 0.f};
#pragma unroll
      for (int ii = 0; ii < 8; ++ii) {
        const int i = tg * 8 + ii;
        f32x2 xg = gb2;
#pragma unroll
        for (int r4 = 0; r4 < 4; ++r4) {
          const f32x4 l4 = *(const f32x4*)(LR + i * 16 + r4 * 4);
          xg += (f32x2){l4[0], l4[0]} * gup2[r4 * 4 + 0];
          xg += (f32x2){l4[1], l4[1]} * gup2[r4 * 4 + 1];
          xg += (f32x2){l4[2], l4[2]} * gup2[r4 * 4 + 2];
          xg += (f32x2){l4[3], l4[3]} * gup2[r4 * 4 + 3];
        }
        f32x2 ls;
        ls[0] = fminf(xg[0], 0.f) - 0.69314718056f * __builtin_amdgcn_logf(1.f + __expf(-fabsf(xg[0])));
        ls[1] = fminf(xg[1], 0.f) - 0.69314718056f * __builtin_amdgcn_logf(1.f + __expf(-fabsf(xg[1])));
        cum += ls * (1.f / 16.f);
        bl[ii] = cum;
      }
      *(f32x2*)(GT + (tg * 64 + c2) * 2) = cum;
      __syncthreads();
      {
        f32x2 offs = (f32x2){0.f, 0.f}, total = (f32x2){0.f, 0.f};
#pragma unroll
        for (int g2 = 0; g2 < 8; ++g2) { const f32x2 gv = *(const f32x2*)(GT + (g2 * 64 + c2) * 2); total += gv; if (g2 < tg) offs += gv; }
        f32x2 krv[8];
        f32x2 etot; etot[0] = __expf(total[0]); etot[1] = __expf(total[1]);
#pragma unroll
        for (int ii = 0; ii < 8; ++ii) {
          const int i = tg * 8 + ii;
          const f32x2 bv = bl[ii] + offs;
          f32x2 eb, ebi;
          eb[0] = __expf(bv[0]); eb[1] = __expf(bv[1]);
          ebi[0] = __builtin_amdgcn_rcpf(eb[0]); ebi[1] = __builtin_amdgcn_rcpf(eb[1]);
          const f32x2 qraw = (f32x2){__uint_as_float(qr[ii] << 16), __uint_as_float(qr[ii] & 0xffff0000u)};
          const f32x2 kraw = (f32x2){__uint_as_float(kr[ii] << 16), __uint_as_float(kr[ii] & 0xffff0000u)};
          const f32x2 qv = qraw * 0.08838834764831845f * eb;
          const f32x2 kv = kraw * ebi;
          *(unsigned*)(QT + i * 136 + 2 * c2) = pk_bf16(qv[0], qv[1]);
          *(unsigned*)(KT + i * 136 + 2 * c2) = pk_bf16(kv[0], kv[1]);
          krv[ii] = kv * etot;
        }
        *(uint4*)(KRT + swz64(2 * c2, tg)) = make_uint4(pk_bf16(krv[0][0], krv[1][0]), pk_bf16(krv[2][0], krv[3][0]), pk_bf16(krv[4][0], krv[5][0]), pk_bf16(krv[6][0], krv[7][0]));
        *(uint4*)(KRT + swz64(2 * c2 + 1, tg)) = make_uint4(pk_bf16(krv[0][1], krv[1][1]), pk_bf16(krv[2][1], krv[3][1]), pk_bf16(krv[4][1], krv[5][1]), pk_bf16(krv[6][1], krv[7][1]));
        *(uint4*)(VT + swz64(2 * c2, tg)) = make_uint4((vr[0] & 0xffffu) | (vr[1] << 16), (vr[2] & 0xffffu) | (vr[3] << 16), (vr[4] & 0xffffu) | (vr[5] << 16), (vr[6] & 0xffffu) | (vr[7] << 16));
        *(uint4*)(VT + swz64(2 * c2 + 1, tg)) = make_uint4((vr[0] >> 16) | (vr[1] & 0xffff0000u), (vr[2] >> 16) | (vr[3] & 0xffff0000u), (vr[4] >> 16) | (vr[5] & 0xffff0000u), (vr[6] >> 16) | (vr[7] & 0xffff0000u));
        if (tg == 0) *(f32x2*)(DEC + 2 * c2) = etot;
      }
      if (ci + 1 < 32) GLA_LOAD_RAW(ci + 1);
      __syncthreads();
#pragma unroll
      for (int tt = 0; tt < 2; ++tt) {
        const int tile = wid * 2 + tt; const int it = tile >> 2, jt = tile & 3;
        f32x4 acc = (f32x4){0.f, 0.f, 0.f, 0.f};
#pragma unroll
        for (int ks = 0; ks < 4; ++ks) {
          const bf16x8 a_op = *(const bf16x8*)(KT + (jt * 16 + fr) * 136 + ks * 32 + fq * 8);
          const bf16x8 b_op = *(const bf16x8*)(QT + (it * 16 + fr) * 136 + ks * 32 + fq * 8);
          acc = __builtin_amdgcn_mfma_f32_16x16x32_bf16(a_op, b_op, acc, 0, 0, 0);
        }
        const int i = it * 16 + fr, j0 = jt * 16 + fq * 4;
        const float p0 = (j0 + 0 <= i) ? acc[0] : 0.f, p1 = (j0 + 1 <= i) ? acc[1] : 0.f;
        const float p2 = (j0 + 2 <= i) ? acc[2] : 0.f, p3 = (j0 + 3 <= i) ? acc[3] : 0.f;
        uint2 o; o.x = pk_bf16(p0, p1); o.y = pk_bf16(p2, p3);
        *(uint2*)(PP + swz64(i, j0 >> 3) + (j0 & 7)) = o;
      }
      __syncthreads();
      {
        f32x4 acco[4];
#pragma unroll
        for (int mi = 0; mi < 4; ++mi) acco[mi] = (f32x4){0.f, 0.f, 0.f, 0.f};
#pragma unroll
        for (int ks = 0; ks < 2; ++ks) {
          const bf16x8 a_op = *(const bf16x8*)(VT + swz64(wid * 16 + fr, ks * 4 + fq));
#pragma unroll
          for (int mi = 0; mi < 4; ++mi) {
            const bf16x8 b_op = *(const bf16x8*)(PP + swz64(mi * 16 + fr, ks * 4 + fq));
            acco[mi] = __builtin_amdgcn_mfma_f32_16x16x32_bf16(a_op, b_op, acco[mi], 0, 0, 0);
          }
        }
#pragma unroll
        for (int ks = 0; ks < 4; ++ks) {
          const bf16x8 a_op = *(const bf16x8*)(ST + (wid * 16 + fr) * 136 + ks * 32 + fq * 8);
#pragma unroll
          for (int mi = 0; mi < 4; ++mi) {
            const bf16x8 b_op = *(const bf16x8*)(QT + (mi * 16 + fr) * 136 + ks * 32 + fq * 8);
            acco[mi] = __builtin_amdgcn_mfma_f32_16x16x32_bf16(a_op, b_op, acco[mi], 0, 0, 0);
          }
        }
#pragma unroll
        for (int mi = 0; mi < 4; ++mi) {
          const int i = mi * 16 + fr;
          const int s = ci * 64 + i; const int t = d ? (T_ - 1 - s) : s;
          uint2 o; o.x = pk_bf16(acco[mi][0], acco[mi][1]); o.y = pk_bf16(acco[mi][2], acco[mi][3]);
          *(uint2*)(p.go + ((size_t)d * NTOK + (size_t)b * T_ + t) * DM + h * 256 + vh * 128 + wid * 16 + fq * 4) = o;
        }
      }
      bf16x8 vfr[2];
#pragma unroll
      for (int ks = 0; ks < 2; ++ks) vfr[ks] = *(const bf16x8*)(VT + swz64(wid * 16 + fr, ks * 4 + fq));
#pragma unroll
      for (int ct = 0; ct < 8; ++ct) {
        const f32x4 dec = *(const f32x4*)(DEC + ct * 16 + fq * 4);
        accs[ct] = accs[ct] * dec;
#pragma unroll
        for (int ks = 0; ks < 2; ++ks) {
          const bf16x8 a_op = *(const bf16x8*)(KRT + swz64(ct * 16 + fr, ks * 4 + fq));
          accs[ct] = __builtin_amdgcn_mfma_f32_16x16x32_bf16(a_op, vfr[ks], accs[ct], 0, 0, 0);
        }
        uint2 o; o.x = pk_bf16(accs[ct][0], accs[ct][1]); o.y = pk_bf16(accs[ct][2], accs[ct][3]);
        *(uint2*)(ST + (wid * 16 + fr) * 136 + ct * 16 + fq * 4) = o;
      }
      __syncthreads();
    }
  }
}

__device__ __forceinline__ void phase_gla_fin(const Params& p) {
  const int lane = threadIdx.x & 63, wid = threadIdx.x >> 6;
  const int n0 = lane * 16;
  float ng[16];
#pragma unroll
  for (int j = 0; j < 16; ++j) ng[j] = p.norm_g[n0 + j];
  const int stride = gridDim.x * 8;
  for (int tok0 = blockIdx.x * 8 + wid; tok0 < NTOK; tok0 += 2 * stride) {
    uint4 av[2][2], bv[2][2], gv[2][2];
#pragma unroll
    for (int r = 0; r < 2; ++r) {
      const int tok = tok0 + r * stride;
      if (tok < NTOK) {
        av[r][0] = *(const uint4*)(p.go + (size_t)tok * DM + n0); av[r][1] = *(const uint4*)(p.go + (size_t)tok * DM + n0 + 8);
        bv[r][0] = *(const uint4*)(p.go + ((size_t)NTOK + tok) * DM + n0); bv[r][1] = *(const uint4*)(p.go + ((size_t)NTOK + tok) * DM + n0 + 8);
        gv[r][0] = *(const uint4*)(p.proj + (size_t)tok * N1P + 2048 + n0); gv[r][1] = *(const uint4*)(p.proj + (size_t)tok * N1P + 2048 + n0 + 8);
      }
    }
#pragma unroll
    for (int r = 0; r < 2; ++r) {
      const int tok = tok0 + r * stride;
      if (tok < NTOK) {
        const unsigned aw[8] = {av[r][0].x, av[r][0].y, av[r][0].z, av[r][0].w, av[r][1].x, av[r][1].y, av[r][1].z, av[r][1].w};
        const unsigned bw[8] = {bv[r][0].x, bv[r][0].y, bv[r][0].z, bv[r][0].w, bv[r][1].x, bv[r][1].y, bv[r][1].z, bv[r][1].w};
        const unsigned gw[8] = {gv[r][0].x, gv[r][0].y, gv[r][0].z, gv[r][0].w, gv[r][1].x, gv[r][1].y, gv[r][1].z, gv[r][1].w};
        float o[16]; float sq = 0.f;
#pragma unroll
        for (int j = 0; j < 8; ++j) {
          o[2 * j] = __uint_as_float(aw[j] << 16) + __uint_as_float(bw[j] << 16);
          o[2 * j + 1] = __uint_as_float(aw[j] & 0xffff0000u) + __uint_as_float(bw[j] & 0xffff0000u);
          sq += o[2 * j] * o[2 * j] + o[2 * j + 1] * o[2 * j + 1];
        }
        sq += dppf0<0xB1>(sq); sq += dppf0<0x4E>(sq); sq += dppf0<0x141>(sq); sq += dppf0<0x140>(sq);
        const float rs = rsqrtf(sq * (1.f / 256.f) + 1e-6f);
        unsigned ow[8];
#pragma unroll
        for (int j = 0; j < 8; ++j) {
          const float ga = __uint_as_float(gw[j] << 16), gb2 = __uint_as_float(gw[j] & 0xffff0000u);
          ow[j] = pk_bf16(o[2 * j] * rs * ng[2 * j] * siluf_(ga), o[2 * j + 1] * rs * ng[2 * j + 1] * siluf_(gb2));
        }
        *(uint4*)(p.ycat + (size_t)tok * DM + n0) = make_uint4(ow[0], ow[1], ow[2], ow[3]);
        *(uint4*)(p.ycat + (size_t)tok * DM + n0 + 8) = make_uint4(ow[4], ow[5], ow[6], ow[7]);
      }
    }
  }
}

__device__ __forceinline__ void phase_dump(const Params& p, int mode) {
  for (size_t i = (size_t)blockIdx.x * NTHR + threadIdx.x; i < (size_t)NTOK * DM; i += (size_t)gridDim.x * NTHR) {
    const size_t tok = i >> 10; const int n = (int)(i & 1023);
    float v = 0.f;
    if (mode == 1) {
      v = bf2f(p.proj[tok * N0P + n]) + bf2f(p.proj[tok * N0P + 1024 + n]) + bf2f(p.proj[tok * N0P + 2048 + n]);
      if (n < 768) v += bf2f(p.proj[tok * N0P + 3072 + n]);
    } else if (mode == 2) {
      if (n < 512) v = bf2f(p.ycat[tok * DM + n]);
      else v = bf2f(p.ys[tok * 512 + (n - 512)]) + bf2f(p.ys[((size_t)NTOK + tok) * 512 + (n - 512)]) + ((n < 520) ? p.beta[tok * 8 + (n - 512)] + p.beta[((size_t)NTOK + tok) * 8 + (n - 512)] : 0.f);
    } else if (mode == 3) {
      v = bf2f(p.ycat[tok * DM + n]);
    } else if (mode == 4) {
      v = bf2f(p.xb[i]) + bf2f(p.wt0[i % ((size_t)N0P * DM)]) + bf2f(p.wt1[i % ((size_t)N1P * DM)]) + bf2f(p.wto0[i % ((size_t)DM * DM)]) + bf2f(p.wto1[i % ((size_t)DM * DM)]);
    }
    p.out[i] = v;
  }
}

#define XB_TMO      128
#define XB_XCNT(j)  (256  + 64 * (j))
#define XB_XSUB(j)  (1280 + 64 * (j))
#define XB_XGEN(j)  (2304 + 64 * (j))
#define XB_TOP      3328
#define XB_TOPGEN   3392
#define XCD_BAR_WORDS 3456
#define XB_SPIN_CAP (1u << 18)
#define XB_LAS __attribute__((address_space(3)))
__device__ __forceinline__ unsigned xb_ld(unsigned* p)              { return __hip_atomic_load(p, __ATOMIC_RELAXED, __HIP_MEMORY_SCOPE_AGENT); }
__device__ __forceinline__ unsigned xb_add(unsigned* p, unsigned v) { return __hip_atomic_fetch_add(p, v, __ATOMIC_RELAXED, __HIP_MEMORY_SCOPE_AGENT); }
__device__ __forceinline__ unsigned xb_xcc_id() { return (unsigned)__builtin_amdgcn_s_getreg((3 << 11) | 20) & 0xFu; }
#define XB_SPIN(cond, bar) do { unsigned _sp = 0; while (cond) { __builtin_amdgcn_s_sleep(1); \
    if ((++_sp & 255u) == 0u) { if (xb_ld(&(bar)[XB_TMO])) break; if (_sp > XB_SPIN_CAP) { atomicAdd(&(bar)[XB_TMO], 1u); break; } } } } while (0)
struct XcdBarrier { unsigned* bar; unsigned x; volatile XB_LAS unsigned* st; };
__device__ __forceinline__ XcdBarrier xcd_barrier_post(unsigned* bar, volatile XB_LAS unsigned* st) {
  XcdBarrier b; b.bar = bar; b.x = xb_xcc_id(); b.st = st;
  if (threadIdx.x == 0) (void)xb_add(&bar[XB_XCNT(b.x)], 1u);
  return b;
}
__device__ __forceinline__ void xcd_barrier_complete(unsigned* bar, unsigned x, unsigned& nloc, unsigned& nx) {
  const unsigned G = gridDim.x * gridDim.y * gridDim.z;
  unsigned sum, cnt, mine, sp = 0u;
  for (;;) {
    sum = 0u; cnt = 0u; mine = 0u;
#pragma unroll
    for (unsigned j = 0; j < 16; ++j) { const unsigned c = xb_ld(&bar[XB_XCNT(j)]); sum += c; cnt += (c > 0u) ? 1u : 0u; mine = (j == x) ? c : mine; }
    if (sum == G) break;
    __builtin_amdgcn_s_sleep(1);
    if ((++sp & 255u) == 0u) { if (xb_ld(&bar[XB_TMO])) break; if (sp > XB_SPIN_CAP) { atomicAdd(&bar[XB_TMO], 1u); break; } }
  }
  nloc = mine > 0u ? mine : 1u; nx = cnt > 0u ? cnt : 1u;
}
__device__ __forceinline__ void xcd_barrier(const XcdBarrier& b) {
  asm volatile("s_waitcnt vmcnt(0)" ::: "memory");
  __syncthreads();
  if (threadIdx.x == 0) {
    unsigned* bar = b.bar;
    __builtin_amdgcn_s_waitcnt(0);
    unsigned nloc = b.st[0], nx = b.st[1];
    if (nloc == 0u) { xcd_barrier_complete(bar, b.x, nloc, nx); b.st[0] = nloc; b.st[1] = nx; }
    const unsigned old = xb_add(&bar[XB_XSUB(b.x)], 1u);
    const unsigned gen = old / nloc;
    if (old + 1u == (gen + 1u) * nloc) {
      __builtin_amdgcn_fence(__ATOMIC_RELEASE, "agent");
      asm volatile("s_waitcnt vmcnt(0)" ::: "memory");
      const unsigned og = xb_add(&bar[XB_TOP], 1u);
      const unsigned tg = og / nx;
      if (og + 1u == (tg + 1u) * nx) xb_add(&bar[XB_TOPGEN], 1u);
      else XB_SPIN(xb_ld(&bar[XB_TOPGEN]) == tg, bar);
      __builtin_amdgcn_fence(__ATOMIC_ACQUIRE, "agent");
      xb_add(&bar[XB_XGEN(b.x)], 1u);
      asm volatile("s_waitcnt vmcnt(0)" ::: "memory");
    } else {
      XB_SPIN(xb_ld(&bar[XB_XGEN(b.x)]) == gen, bar);
      __builtin_amdgcn_fence(__ATOMIC_ACQUIRE, "agent");
      asm volatile("s_waitcnt vmcnt(0)" ::: "memory");
    }
  }
  __syncthreads();
}

__global__ void __launch_bounds__(NTHR) mega(Params p) {
  __shared__ __attribute__((aligned(16))) char smem[LDS_BYTES];
  cg::grid_group grid = cg::this_grid();
  if (threadIdx.x == 0) *(uint4*)(smem + LDS_BYTES - 16) = make_uint4(0u, 0u, 0u, 0u);
  __syncthreads();
  const XcdBarrier xb = xcd_barrier_post(p.bar, (volatile XB_LAS unsigned*)(smem + LDS_BYTES - 16));
  if (p.ph_hi > 1000) grid.sync();
#define RUN_PHASE(PH, CALL) \
  if (p.ph_lo <= (PH) && (PH) <= p.ph_hi) { CALL; } \
  if (p.ph_lo <= (PH) && (PH) < p.ph_hi) xcd_barrier(xb);
  RUN_PHASE(0, phase_prep(p, smem))
  RUN_PHASE(1, gemm_run(p.xb, p.wt0, N0P, pg8::EpiBf16{p.proj, N0P}, smem))
  RUN_PHASE(2, phase_conv(p, smem); phase_scan(p, smem))
  RUN_PHASE(3, phase_rwkv_fin(p))
  RUN_PHASE(4, gemm_run(p.ycat, p.wto0, DM, pg8::EpiBf16{p.hb, DM}, smem))
  RUN_PHASE(5, phase_ln<true>(p.xb, p.hb, nullptr, p.ln0_g, p.ln0_b, p.x1k))
  RUN_PHASE(6, gemm_run(p.x1k, p.wt1, N1P, pg8::EpiBf16{p.proj, N1P}, smem))
  RUN_PHASE(7, phase_gla(p, smem))
  RUN_PHASE(8, phase_gla_fin(p))
  RUN_PHASE(9, gemm_run(p.ycat, p.wto1, DM, pg8::EpiBf16{p.hb, DM}, smem))
  RUN_PHASE(10, phase_ln<true>(p.x1k, p.hb, p.out, p.ln1_g, p.ln1_b, nullptr))
  RUN_PHASE(11, phase_dump(p, DUMPMODE))
}

extern "C" void kernel_launch(void* const* d_in, const int* in_sizes, int n_in, void* d_out, int out_size,
                              void* d_ws, size_t ws_size, hipStream_t stream) {
  Params p{};
  p.x = (const float*)d_in[0]; p.w_in0 = (const float*)d_in[1]; p.conv_w = (const float*)d_in[2]; p.conv_b = (const float*)d_in[3];
  p.conv_ln_g = (const float*)d_in[4]; p.conv_ln_b = (const float*)d_in[5]; p.mu = (const float*)d_in[6]; p.w0 = (const float*)d_in[7];
  p.w_up = (const float*)d_in[8]; p.a0 = (const float*)d_in[9]; p.a_up = (const float*)d_in[10]; p.k_k = (const float*)d_in[11];
  p.k_a = (const float*)d_in[12]; p.r_k = (const float*)d_in[13]; p.gn_g = (const float*)d_in[14]; p.gn_b = (const float*)d_in[15];
  p.w_out0 = (const float*)d_in[16]; p.ln0_g = (const float*)d_in[17]; p.ln0_b = (const float*)d_in[18];
  p.w_in1 = (const float*)d_in[19]; p.g_up = (const float*)d_in[20]; p.g_bias = (const float*)d_in[21]; p.norm_g = (const float*)d_in[22];
  p.w_out1 = (const float*)d_in[23]; p.ln1_g = (const float*)d_in[24]; p.ln1_b = (const float*)d_in[25];
  p.out = (float*)d_out;
  char* ws = (char*)d_ws;
  size_t off = 0;
  p.xb = (bf16_t*)(ws + off); p.ys = (bf16_t*)(ws + off + ((size_t)64 << 20)); p.go = (bf16_t*)(ws + off); p.hb = (bf16_t*)(ws + off + ((size_t)64 << 20)); off += (size_t)128 << 20;
  p.wt0 = (bf16_t*)(ws + off); off += (size_t)N0P * DM * 2;
  p.wto0 = (bf16_t*)(ws + off); off += (size_t)DM * DM * 2;
  p.wt1 = (bf16_t*)(ws + off); off += (size_t)N1P * DM * 2;
  p.wto1 = (bf16_t*)(ws + off); off += (size_t)DM * DM * 2;
  p.ycat = (bf16_t*)(ws + off); off += (size_t)NTOK * DM * 2;
  p.beta = (float*)(ws + off); off += (size_t)2 * NB_ * T_ * 8 * 4;
  p.proj = (bf16_t*)(ws + off);
  p.x1k = (bf16_t*)(ws + off + (size_t)NTOK * N1P * 2);
  p.bar = (unsigned*)(ws + ((size_t)496 << 20));
  p.ph_lo = 0; p.ph_hi = 10;
  static int grid_blocks = 0;
  if (!grid_blocks) {
    int dev = 0, cus = 0, per_cu = 0;
    hipGetDevice(&dev);
    hipDeviceGetAttribute(&cus, hipDeviceAttributeMultiprocessorCount, dev);
    hipOccupancyMaxActiveBlocksPerMultiprocessor(&per_cu, mega, NTHR, 0);
    if (per_cu < 1) per_cu = 1;
    if (per_cu > 1) per_cu = 1;
    grid_blocks = cus * per_cu;
  }
#ifdef MULTI_LAUNCH
  for (int ph = 0; ph <= MAXPH; ++ph) {
    p.ph_lo = ph; p.ph_hi = ph;
    hipLaunchKernelGGL(mega, dim3(grid_blocks), dim3(NTHR), 0, stream, p);
  }
  p.ph_lo = 11; p.ph_hi = 11;
  hipLaunchKernelGGL(mega, dim3(grid_blocks), dim3(NTHR), 0, stream, p);
#else
  (void)hipMemsetAsync(p.bar, 0, XCD_BAR_WORDS * sizeof(unsigned), stream);
  void* args[] = {&p};
  hipError_t e = hipLaunchCooperativeKernel((void*)mega, dim3(grid_blocks), dim3(NTHR), args, 0, stream);
  if (e != hipSuccess) fprintf(stderr, "cooperative launch failed: %s (grid %d)\n", hipGetErrorString(e), grid_blocks);
#endif
}
```

```cpp
#include <hip/hip_runtime.h>
#include <hip/hip_cooperative_groups.h>
#include <cstdio>
namespace cg = cooperative_groups;

typedef unsigned short bf16_t;
typedef short bf16x8 __attribute__((ext_vector_type(8)));
typedef float f32x4 __attribute__((ext_vector_type(4)));
typedef float f32x2 __attribute__((ext_vector_type(2)));

#define T_ 2048
#define NB_ 16
#define NTOK 32768
#define DM 1024
#define N0 3776
#define N0P 3840
#define N1 3104
#define N1P 3072
#define N1W 3328
#define ALPHA 1.41421356237f
#define NTHR 512
#define LDS_BYTES 139264

#define MAXPH 1
#define DUMPMODE 1

struct Params {
  const float* x; const float* w_in0; const float* conv_w; const float* conv_b; const float* conv_ln_g; const float* conv_ln_b;
  const float* mu; const float* w0; const float* w_up; const float* a0; const float* a_up; const float* k_k; const float* k_a; const float* r_k;
  const float* gn_g; const float* gn_b; const float* w_out0; const float* ln0_g; const float* ln0_b;
  const float* w_in1; const float* g_up; const float* g_bias; const float* norm_g; const float* w_out1; const float* ln1_g; const float* ln1_b;
  float* out;
  bf16_t* xb; bf16_t* ys; bf16_t* go; bf16_t* hb;
  bf16_t* wt0; bf16_t* wto0; bf16_t* wt1; bf16_t* wto1;
  bf16_t* proj; bf16_t* ycat; float* beta; bf16_t* x1k; unsigned* bar; bf16_t* lrb;
  int ph_lo; int ph_hi;
};

typedef __bf16 bf16x2_t __attribute__((ext_vector_type(2)));
__device__ __forceinline__ unsigned pk_bf16(float lo, float hi) {
  const f32x2 v = (f32x2){lo, hi};
  const bf16x2_t b = __builtin_convertvector(v, bf16x2_t);
  return __builtin_bit_cast(unsigned, b);
}
__device__ __forceinline__ bf16_t f2bf(float v) { return (bf16_t)(pk_bf16(v, 0.f) & 0xffffu); }
__device__ __forceinline__ float bf2f(bf16_t v) { return __uint_as_float(((unsigned)v) << 16); }
__device__ __forceinline__ float sigmoidf_(float x) { return __builtin_amdgcn_rcpf(1.f + __expf(-x)); }
__device__ __forceinline__ float siluf_(float x) { return x * __builtin_amdgcn_rcpf(1.f + __expf(-x)); }
__device__ __forceinline__ float tanhf_(float x) { return 1.f - 2.f * __builtin_amdgcn_rcpf(1.f + __expf(2.f * x)); }
template <int CTRL> __device__ __forceinline__ float dppf0(float x) {
  return __int_as_float(__builtin_amdgcn_update_dpp(0, __float_as_int(x), CTRL, 0xF, 0xF, true));
}
__device__ __forceinline__ float wave_sum(float v) {
  v += dppf0<0xB1>(v); v += dppf0<0x4E>(v); v += dppf0<0x141>(v); v += dppf0<0x140>(v);
  const int vi = __float_as_int(v);
  const float r0 = __int_as_float(__builtin_amdgcn_readlane(vi, 0)), r1 = __int_as_float(__builtin_amdgcn_readlane(vi, 16));
  const float r2 = __int_as_float(__builtin_amdgcn_readlane(vi, 32)), r3 = __int_as_float(__builtin_amdgcn_readlane(vi, 48));
  return (r0 + r1) + (r2 + r3);
}
template <int CTRL> __device__ __forceinline__ float dppf(float x) {
  return __int_as_float(__builtin_amdgcn_update_dpp(0, __float_as_int(x), CTRL, 0xF, 0xF, true));
}

__device__ __forceinline__ void wtrans_tile(const float* __restrict__ W, int N, bf16_t* __restrict__ Wt, int kt, int nt, float* tile) {
  const int tid = threadIdx.x;
  const int k0 = kt * 64, n0 = nt * 64;
  {
    const int r = tid >> 4, c4 = (tid & 15) * 4;
#pragma unroll
    for (int hh = 0; hh < 2; ++hh) {
      const int rr = r + hh * 32;
      float4 v = make_float4(0.f, 0.f, 0.f, 0.f);
      if (n0 + c4 < N) v = *(const float4*)(W + (size_t)(k0 + rr) * N + n0 + c4);
      tile[rr * 65 + c4 + 0] = v.x; tile[rr * 65 + c4 + 1] = v.y; tile[rr * 65 + c4 + 2] = v.z; tile[rr * 65 + c4 + 3] = v.w;
    }
  }
  __syncthreads();
  {
    const int n = tid >> 3, k8 = (tid & 7) * 8;
    float v[8];
#pragma unroll
    for (int i = 0; i < 8; ++i) v[i] = tile[(k8 + i) * 65 + n];
    uint4 o; o.x = pk_bf16(v[0], v[1]); o.y = pk_bf16(v[2], v[3]); o.z = pk_bf16(v[4], v[5]); o.w = pk_bf16(v[6], v[7]);
    *(uint4*)(Wt + (size_t)(n0 + n) * DM + k0 + k8) = o;
  }
  __syncthreads();
}

__device__ __forceinline__ void phase_prep(const Params& p, char* smem) {
  const size_t n8 = (size_t)NTOK * DM / 8;
  for (size_t i = (size_t)blockIdx.x * NTHR + threadIdx.x; i < n8; i += (size_t)gridDim.x * NTHR) {
    const float4* src = (const float4*)(p.x) + i * 2;
    float4 a = src[0], b = src[1];
    uint4 o; o.x = pk_bf16(a.x, a.y); o.y = pk_bf16(a.z, a.w); o.z = pk_bf16(b.x, b.y); o.w = pk_bf16(b.z, b.w);
    ((uint4*)p.xb)[i] = o;
  }
  float* tile = (float*)smem;
  for (int u = blockIdx.x; u < 2304; u += gridDim.x) {
    if (u < 960) wtrans_tile(p.w_in0, N0, p.wt0, u / 60, u % 60, tile);
    else if (u < 1216) { int v = u - 960; wtrans_tile(p.w_out0, DM, p.wto0, v / 16, v % 16, tile); }
    else if (u < 2048) { int v = u - 1216; wtrans_tile(p.w_in1, N1, p.wt1, v / 52, v % 52, tile); }
    else { int v = u - 2048; wtrans_tile(p.w_out1, DM, p.wto1, v / 16, v % 16, tile); }
  }
}

namespace pg8 {
#define PG8_LAS __attribute__((address_space(3)))
constexpr int BM = 256, BK = 64, HALF = 128, HTB = HALF * BK * 2, NXCD = 8, WGM = 8;
__device__ __forceinline__ int lds_byte(int r, int c) { const int st = (r >> 4) * 2 + (c >> 5), rr = r & 15, cc = c & 31, ob = rr * 64 + cc * 2; return st * 1024 + (ob ^ (((ob >> 9) & 1) << 5)); }
__device__ __forceinline__ void stage_rc(int b, int& R, int& C) { const int st = b / 1024, sb = b % 1024, swz = sb ^ (((sb >> 9) & 1) << 5); R = (st >> 1) * 16 + swz / 64; C = (st & 1) * 32 + (swz % 64) / 2; }
__device__ __forceinline__ int perm32(int rho) { const int n = rho >> 4, i = rho & 15; return 8 * (i >> 2) + 4 * n + (i & 3); }
struct Unit { int pm, pn; };
struct Gemm { const bf16_t* A; const bf16_t* Bt; int M, N, K; };
struct StaticOrder {
  int nM, nN, nwg, G, c;
  __device__ void init(int M, int N, int G_, int c_) { nM = M / BM; nN = N / BM; nwg = nM * nN; G = G_; c = c_; }
  __device__ bool next(int i, Unit& u) const {
    const long L = (long)i * G + c; if (L >= nwg) return false;
    int wgid = (int)L; { const int q = nwg / NXCD, r = nwg % NXCD, xcd = wgid % NXCD, off = wgid / NXCD; wgid = (xcd < r ? xcd * (q + 1) : r * (q + 1) + (xcd - r) * q) + off; }
    const int nig = WGM * nN, gid = wgid / nig, fm = gid * WGM, gsz = (nM - fm) < WGM ? (nM - fm) : WGM;
    u.pm = fm + ((wgid % nig) % gsz); u.pn = (wgid % nig) / gsz; return true;
  }
};
struct EpiBf16 {
  static constexpr bool PERM = true;
  bf16_t* O; int ldc;
  __device__ __forceinline__ void operator()(const f32x4 (&acc)[2][2][4][2], const Unit& u, int wr, int wc, int fr, int fq) const {
    const int row0 = u.pm * BM + wr * 64 + fr, col0 = u.pn * BM + wc * 32 + 8 * fq;
#pragma unroll
    for (int ai = 0; ai < 2; ++ai)
#pragma unroll
      for (int m = 0; m < 4; ++m) {
        bf16_t* rowp = O + (size_t)(row0 + ai * HALF + m * 16) * ldc + col0;
#pragma unroll
        for (int bj = 0; bj < 2; ++bj) {
          const f32x4 v0 = acc[ai][bj][m][0], v1 = acc[ai][bj][m][1];
          uint4 o; o.x = pk_bf16(v0[0], v0[1]); o.y = pk_bf16(v0[2], v0[3]); o.z = pk_bf16(v1[0], v1[1]); o.w = pk_bf16(v1[2], v1[3]);
          *(uint4*)(rowp + bj * HALF) = o;
        }
      }
  }
};
struct EpiRes {
  static constexpr bool PERM = false;
  const float* X; float* Y;
  __device__ __forceinline__ void operator()(const f32x4 (&acc)[2][2][4][2], const Unit& u, int wr, int wc, int fr, int fq) const {
    const int row0 = u.pm * BM + wr * 64 + fr, col0 = u.pn * BM + wc * 32 + 4 * fq;
#pragma unroll
    for (int ai = 0; ai < 2; ++ai)
#pragma unroll
      for (int m = 0; m < 4; ++m) {
        const size_t ro = (size_t)(row0 + ai * HALF + m * 16) * DM + col0;
#pragma unroll
        for (int bj = 0; bj < 2; ++bj)
#pragma unroll
          for (int n = 0; n < 2; ++n) {
            const f32x4 xr = *(const f32x4*)(X + ro + bj * HALF + n * 16);
            *(f32x4*)(Y + ro + bj * HALF + n * 16) = xr * ALPHA + acc[ai][bj][m][n];
          }
      }
  }
};

template <class Epi>
__device__ __forceinline__ void gemm_phase(PG8_LAS unsigned char* lds, const Gemm g, const StaticOrder& S, const Epi& E) {
  const int tid = threadIdx.x, wid = __builtin_amdgcn_readfirstlane(tid >> 6), lane = tid & 63, wr = wid >> 2, wc = wid & 3, fr = lane & 15, fq = lane >> 4;
  const int K = g.K, nt = K / BK;
  unsigned voffA[2], voffB[2];
#pragma unroll
  for (int i = 0; i < 2; ++i) { int R, C; stage_rc(tid * 16 + i * 8192, R, C); const int Rb = Epi::PERM ? ((R & ~31) + perm32(R & 31)) : R;
    voffA[i] = (unsigned)(R * K + C) * 2u; voffB[i] = (unsigned)(Rb * K + C) * 2u; }
  const size_t kstep = (size_t)(BK * 2);
  const size_t hstep = (size_t)HALF * K * 2;
  const size_t tstep = 2 * hstep;
  const unsigned ldsw = (unsigned)wid * 1024u;
  const int aoff = lds_byte(wr * 64 + fr, fq * 8), boff = lds_byte(wc * 32 + fr, fq * 8);
#define PG8_SA(b, h) (((b) * 2 + (h)) * HTB)
#define PG8_SB(b, h) ((4 + (b) * 2 + (h)) * HTB)
#define PG8_STAGE(bufoff, gbase, voff) do { _Pragma("unroll") for (int _i = 0; _i < 2; ++_i) \
    __builtin_amdgcn_global_load_lds((const unsigned*)((const char*)(gbase) + (voff)[_i]), (PG8_LAS unsigned*)(lds + (bufoff) + ldsw + _i * 8192), 16, 0, 0); } while (0)
#define PG8_LDA(dst, b, h) do { _Pragma("unroll") for (int m = 0; m < 4; ++m) _Pragma("unroll") for (int k = 0; k < 2; ++k) dst[m][k] = *(const PG8_LAS bf16x8*)(lds + PG8_SA(b, h) + aoff + m * 2048 + k * 1024); } while (0)
#define PG8_LDB(dst, b, h) do { _Pragma("unroll") for (int n = 0; n < 2; ++n) _Pragma("unroll") for (int k = 0; k < 2; ++k) dst[n][k] = *(const PG8_LAS bf16x8*)(lds + PG8_SB(b, h) + boff + n * 2048 + k * 1024); } while (0)
#define PG8_MMA(ai, bj, At, Bt) do { __builtin_amdgcn_s_setprio(1); _Pragma("unroll") for (int m = 0; m < 4; ++m) _Pragma("unroll") for (int n = 0; n < 2; ++n) _Pragma("unroll") for (int k = 0; k < 2; ++k) \
    acc[ai][bj][m][n] = __builtin_amdgcn_mfma_f32_16x16x32_bf16(Bt[n][k], At[m][k], acc[ai][bj][m][n], 0, 0, 0); __builtin_amdgcn_s_setprio(0); } while (0)
#define PG8_WAIT_V(n) asm volatile("s_waitcnt vmcnt(" #n ")" ::: "memory")
#define PG8_WAIT_L(n) asm volatile("s_waitcnt lgkmcnt(" #n ")" ::: "memory")
#define PG8_BAR __builtin_amdgcn_s_barrier()
#define PG8_SCHED __builtin_amdgcn_sched_barrier(0)
  Unit cur, nxt; int ui = 0;
  if (!S.next(0, cur)) return;
  f32x4 acc[2][2][4][2];
#pragma unroll
  for (int a = 0; a < 2; ++a)
#pragma unroll
    for (int b = 0; b < 2; ++b)
#pragma unroll
      for (int m = 0; m < 4; ++m)
#pragma unroll
        for (int n = 0; n < 2; ++n) acc[a][b][m][n] = (f32x4){0.f, 0.f, 0.f, 0.f};
  bf16x8 At[4][2], B0[2][2], B1[2][2];
  const char* cA = (const char*)g.A + (size_t)cur.pm * tstep; const char* cB = (const char*)g.Bt + (size_t)cur.pn * tstep;
  PG8_STAGE(PG8_SB(0, 0), cB, voffB); PG8_STAGE(PG8_SA(0, 0), cA, voffA); PG8_STAGE(PG8_SB(0, 1), cB + hstep, voffB); PG8_STAGE(PG8_SA(0, 1), cA + hstep, voffA);
  if (wr == 1) PG8_BAR;
  PG8_WAIT_V(4); PG8_BAR;
  PG8_STAGE(PG8_SB(1, 0), cB + kstep, voffB); PG8_STAGE(PG8_SA(1, 0), cA + kstep, voffA); PG8_STAGE(PG8_SB(1, 1), cB + hstep + kstep, voffB);
  PG8_WAIT_V(6); PG8_BAR;
  for (;;) {
    const bool has_next = S.next(ui + 1, nxt);
    const char* nA = has_next ? (const char*)g.A + (size_t)nxt.pm * tstep : cA; const char* nB = has_next ? (const char*)g.Bt + (size_t)nxt.pn * tstep : cB;
    for (int t = 0; t < nt; t += 2) {
      const bool last = (t == nt - 2);
      const char* a1 = cA + (size_t)(t + 1) * kstep;
      const char* a2 = last ? nA : cA + (size_t)(t + 2) * kstep; const char* b2 = last ? nB : cB + (size_t)(t + 2) * kstep;
      const char* a3 = a2 + kstep; const char* b3 = b2 + kstep;
      PG8_LDB(B0, 0, 0); PG8_SCHED; PG8_LDA(At, 0, 0); PG8_STAGE(PG8_SA(1, 1), a1 + hstep, voffA);
      PG8_WAIT_L(8); PG8_BAR; PG8_WAIT_L(0); PG8_MMA(0, 0, At, B0); PG8_BAR; PG8_SCHED;
      PG8_LDB(B1, 0, 1); PG8_STAGE(PG8_SB(0, 0), b2, voffB);
      PG8_BAR; PG8_WAIT_L(0); PG8_MMA(0, 1, At, B1); PG8_BAR;
      PG8_LDA(At, 0, 1); PG8_STAGE(PG8_SA(0, 0), a2, voffA);
      PG8_BAR; PG8_WAIT_L(0); PG8_MMA(1, 0, At, B0); PG8_BAR; PG8_SCHED;
      PG8_STAGE(PG8_SB(0, 1), b2 + hstep, voffB);
      PG8_WAIT_V(6); PG8_BAR; PG8_MMA(1, 1, At, B1); PG8_BAR;
      PG8_LDB(B0, 1, 0); PG8_SCHED; PG8_LDA(At, 1, 0); PG8_STAGE(PG8_SA(0, 1), a2 + hstep, voffA);
      PG8_WAIT_L(8); PG8_BAR; PG8_WAIT_L(0); PG8_MMA(0, 0, At, B0); PG8_BAR; PG8_SCHED;
      PG8_LDB(B1, 1, 1); PG8_STAGE(PG8_SB(1, 0), b3, voffB);
      PG8_BAR; PG8_WAIT_L(0); PG8_MMA(0, 1, At, B1); PG8_BAR;
      PG8_LDA(At, 1, 1); PG8_STAGE(PG8_SA(1, 0), a3, voffA);
      PG8_BAR; PG8_WAIT_L(0); PG8_MMA(1, 0, At, B0); PG8_BAR; PG8_SCHED;
      PG8_STAGE(PG8_SB(1, 1), b3 + hstep, voffB);
      PG8_WAIT_V(6); PG8_BAR; PG8_MMA(1, 1, At, B1); PG8_BAR;
    }
    E(acc, cur, wr, wc, fr, fq);
    if (!has_next) break;
#pragma unroll
    for (int a = 0; a < 2; ++a)
#pragma unroll
      for (int b = 0; b < 2; ++b)
#pragma unroll
        for (int m = 0; m < 4; ++m)
#pragma unroll
          for (int n = 0; n < 2; ++n) acc[a][b][m][n] = (f32x4){0.f, 0.f, 0.f, 0.f};
    cur = nxt; cA = nA; cB = nB; ++ui;
  }
  PG8_WAIT_V(0);
  if (wr == 0) PG8_BAR;
  PG8_BAR;
#undef PG8_SA
#undef PG8_SB
#undef PG8_STAGE
#undef PG8_LDA
#undef PG8_LDB
#undef PG8_MMA
#undef PG8_WAIT_V
#undef PG8_WAIT_L
#undef PG8_BAR
#undef PG8_SCHED
}
}

template <class Epi>
__device__ __forceinline__ void gemm_run(const bf16_t* A, const bf16_t* Bt, int N, const Epi& E, char* smem) {
  pg8::Gemm g; g.A = A; g.Bt = Bt; g.M = NTOK; g.N = N; g.K = DM;
  pg8::StaticOrder S; S.init(NTOK, N, (int)gridDim.x, (int)blockIdx.x);
  pg8::gemm_phase<Epi>((PG8_LAS unsigned char*)smem, g, S, E);
  __syncthreads();
}

__device__ __forceinline__ void phase_conv(const Params& p, char* smem) {
  float* u = (float*)smem;
  const int tid = threadIdx.x, lane = tid & 63, wid = tid >> 6;
  const int c = tid;
  float w[31];
#pragma unroll
  for (int j = 0; j < 31; ++j) w[j] = p.conv_w[j * 512 + c];
  const float bias = p.conv_b[c];
  const int c8 = lane * 8;
  for (int tile = blockIdx.x; tile < 1024; tile += gridDim.x) {
    const int b = tile >> 6, t0 = (tile & 63) * 32;
#pragma unroll
    for (int it = 0; it < 8; ++it) {
      const int tt = wid + 8 * it;
      if (tt < 62) {
        const int t = t0 - 15 + tt;
        f32x4 u0 = (f32x4){0.f, 0.f, 0.f, 0.f}, u1 = (f32x4){0.f, 0.f, 0.f, 0.f};
        if (t >= 0 && t < T_) {
          const bf16_t* row = p.proj + (size_t)(b * T_ + t) * N0P;
          const uint4 v4 = *(const uint4*)(row + c8), g4 = *(const uint4*)(row + 512 + c8);
          const unsigned vw[4] = {v4.x, v4.y, v4.z, v4.w}, gw[4] = {g4.x, g4.y, g4.z, g4.w};
          float uu[8];
#pragma unroll
          for (int j = 0; j < 4; ++j) {
            uu[2 * j] = __uint_as_float(vw[j] << 16) * sigmoidf_(__uint_as_float(gw[j] << 16));
            uu[2 * j + 1] = __uint_as_float(vw[j] & 0xffff0000u) * sigmoidf_(__uint_as_float(gw[j] & 0xffff0000u));
          }
          u0 = (f32x4){uu[0], uu[1], uu[2], uu[3]}; u1 = (f32x4){uu[4], uu[5], uu[6], uu[7]};
        }
        *(f32x4*)(u + tt * 512 + c8) = u0; *(f32x4*)(u + tt * 512 + c8 + 4) = u1;
      }
    }
    __syncthreads();
    {
      float uin[47];
#pragma unroll
      for (int hh = 0; hh < 2; ++hh) {
#pragma unroll
        for (int r = 0; r < 46; ++r) uin[r] = u[(hh * 16 + r) * 512 + c];
        float accs[16];
#pragma unroll
        for (int ti = 0; ti < 16; ++ti) {
          float acc = bias;
#pragma unroll
          for (int j = 0; j < 31; ++j) acc += w[j] * uin[ti + j];
          accs[ti] = acc;
        }
        __syncthreads();
#pragma unroll
        for (int ti = 0; ti < 16; ++ti) u[(hh * 16 + ti) * 512 + c] = accs[ti];
      }
    }
    __syncthreads();
#pragma unroll 2
    for (int ti = wid; ti < 32; ti += 8) {
      const size_t tok = (size_t)b * T_ + t0 + ti;
      const uint4 g4 = *(const uint4*)(p.proj + tok * N0P + 1024 + c8);
      const f32x4 a0 = *(const f32x4*)(u + ti * 512 + c8), a1 = *(const f32x4*)(u + ti * 512 + c8 + 4);
      float v[8] = {a0[0], a0[1], a0[2], a0[3], a1[0], a1[1], a1[2], a1[3]};
      float s = 0.f;
#pragma unroll
      for (int i = 0; i < 8; ++i) s += v[i];
      const float mean = wave_sum(s) * (1.f / 512.f);
      float q = 0.f;
#pragma unroll
      for (int i = 0; i < 8; ++i) { v[i] -= mean; q += v[i] * v[i]; }
      const float rstd = rsqrtf(wave_sum(q) * (1.f / 512.f) + 1e-5f);
      const f32x4 lg0 = *(const f32x4*)(p.conv_ln_g + c8), lg1 = *(const f32x4*)(p.conv_ln_g + c8 + 4);
      const f32x4 lb0 = *(const f32x4*)(p.conv_ln_b + c8), lb1 = *(const f32x4*)(p.conv_ln_b + c8 + 4);
      const unsigned gw[4] = {g4.x, g4.y, g4.z, g4.w};
      unsigned ow[4];
#pragma unroll
      for (int j = 0; j < 4; ++j) {
        const float lga = (j < 2) ? lg0[2 * j] : lg1[2 * j - 4], lgb = (j < 2) ? lg0[2 * j + 1] : lg1[2 * j - 3];
        const float lba = (j < 2) ? lb0[2 * j] : lb1[2 * j - 4], lbb = (j < 2) ? lb0[2 * j + 1] : lb1[2 * j - 3];
        float ya = siluf_(v[2 * j] * rstd * lga + lba), yb = siluf_(v[2 * j + 1] * rstd * lgb + lbb);
        ya *= siluf_(__uint_as_float(gw[j] << 16)); yb *= siluf_(__uint_as_float(gw[j] & 0xffff0000u));
        ow[j] = pk_bf16(ya, yb);
      }
      *(uint4*)(p.ycat + tok * DM + c8) = make_uint4(ow[0], ow[1], ow[2], ow[3]);
    }
    __syncthreads();
  }
}

__device__ __forceinline__ void phase_scan(const Params& p, char* smem) {
  bf16_t* WupT = (bf16_t*)smem;
  bf16_t* AupT = (bf16_t*)(smem + 9216);
  float* MU = (float*)(smem + 14336);
  bf16_t* SB = (bf16_t*)(smem + 15488);
  bf16_t* TW = (bf16_t*)(smem + 24704);
  bf16_t* AL = (bf16_t*)(smem + 29312);
  float* WP = (float*)(smem + 31872);
  float* AP = (float*)(smem + 40064);
  float* GT = (float*)(smem + 131200);
  float* GC = (float*)(smem + 133248);
  float* KKv = (float*)(smem + 48256); float* Bv = KKv + 2048; float* KMv = Bv + 2048; float* LWv = KMv + 2048;
  float* Rv = LWv + 2048; float* Vv = Rv + 2048;
  bf16_t* MAK = (bf16_t*)(smem + 48256);
  bf16_t* MRB = (bf16_t*)(smem + 50816);
  bf16_t* MRK = (bf16_t*)(smem + 53376);
  float* MAB = (float*)(smem + 55936);
  float* Wb = (float*)(smem + 60544);
  bf16_t* UT = (bf16_t*)(smem + 69248);
  bf16_t* RAW = (bf16_t*)(smem + 97408);
  bf16_t* AH = (bf16_t*)(smem + 97408);
  bf16_t* BH = (bf16_t*)(smem + 102016);
  bf16_t* KH = (bf16_t*)(smem + 106624);
  bf16_t* RH = (bf16_t*)(smem + 111232);
  bf16_t* BTT = (bf16_t*)(smem + 115840);
  bf16_t* KTT = (bf16_t*)(smem + 120960);
  bf16_t* VT = (bf16_t*)(smem + 126080);
  const int tid = threadIdx.x, lane = tid & 63, wid = tid >> 6;
  const int fr = lane & 15, fq = lane >> 4;
  for (int seq = blockIdx.x; seq < 256; seq += gridDim.x) {
    const int d = seq >> 7, b = (seq >> 3) & 15, h = seq & 7;
    __syncthreads();
    if (tid < 288) MU[tid] = (tid < 192) ? p.mu[(tid >> 6) * 512 + h * 64 + (tid & 63)] : p.mu[1536 + d * 96 + (tid - 192)];
#pragma unroll
    for (int i = 0; i < 8; ++i) { const int e = tid + 512 * i; const int j = e >> 6, c = e & 63; WupT[c * 72 + j] = f2bf(p.w_up[((size_t)d * 64 + j) * 512 + h * 64 + c]); }
#pragma unroll
    for (int i = 0; i < 4; ++i) { const int e = tid + 512 * i; const int j = e >> 6, c = e & 63; AupT[c * 40 + j] = f2bf(p.a_up[((size_t)d * 32 + j) * 512 + h * 64 + c]); }
    const int ptok = tid >> 4, pc4 = (tid & 15) * 4;
    float w0v[4], a0v[4], kkc[4], kac[4], rkc[4];
#pragma unroll
    for (int i = 0; i < 4; ++i) {
      const int ch = h * 64 + pc4 + i;
      w0v[i] = p.w0[d * 512 + ch]; a0v[i] = p.a0[d * 512 + ch]; kkc[i] = p.k_k[ch]; kac[i] = p.k_a[ch]; rkc[i] = p.r_k[ch];
    }
    f32x4 accS[2];
    accS[0] = (f32x4){0.f, 0.f, 0.f, 0.f}; accS[1] = (f32x4){0.f, 0.f, 0.f, 0.f};
    for (int i = tid; i < 64 * 72 / 2; i += NTHR) ((unsigned*)SB)[i] = 0u;
    const bf16_t* pbase = p.proj + (size_t)b * T_ * N0P;
    uint4 pc0, pp0, pn0, pc1, pp1, pn1, pc2, pp2, pn2;
#define SCAN_LD(PC, PP, PN, TOK, CK, CI) do { \
      const int s_ = (CI) * 32 + (TOK); const int t_ = d ? (T_ - 1 - s_) : s_; \
      const int col_ = ((CK) < 24) ? (1536 + ((CK) >> 3) * 512 + h * 64 + ((CK) & 7) * 8) : (3072 + d * 96 + ((CK) - 24) * 8); \
      const bf16_t* g_ = pbase + (size_t)t_ * N0P + col_; \
      PC = *(const uint4*)g_; PP = make_uint4(0u, 0u, 0u, 0u); PN = make_uint4(0u, 0u, 0u, 0u); \
      if (t_ > 0) PP = *(const uint4*)(g_ - N0P); \
      if (t_ < T_ - 1) PN = *(const uint4*)(g_ + N0P); } while (0)
#define SCAN_ITEMS(TID) \
      const int tokA = (TID) / 24, ckA = (TID) - tokA * 24; \
      const int tokB = ((TID) + 512) / 24, ckB = ((TID) + 512) - tokB * 24; \
      const int tokC = (wid < 4) ? ((TID) >> 3) : (((TID) - 256) >> 2), ckC = (wid < 4) ? (24 + ((TID) & 7)) : (32 + (((TID) - 256) & 3));
#define SCAN_LOAD_ALL(CI) do { \
      SCAN_LD(pc0, pp0, pn0, tokA, ckA, CI); \
      if (wid < 4) SCAN_LD(pc1, pp1, pn1, tokB, ckB, CI); \
      if (wid < 6) SCAN_LD(pc2, pp2, pn2, tokC, ckC, CI); } while (0)
    {
      SCAN_ITEMS((int)threadIdx.x)
      pc1 = pp1 = pn1 = pc2 = pp2 = pn2 = make_uint4(0u, 0u, 0u, 0u);
      SCAN_LOAD_ALL(0);
    }
    for (int ci = 0; ci < 64; ++ci) {
      int lz = 0; asm volatile("" : "+v"(lz));
      const int tid = (int)threadIdx.x + lz, lane = tid & 63, fr = lane & 15, fq = lane >> 4, ptok = tid >> 4, pc4 = (tid & 15) * 4;
      SCAN_ITEMS(tid)
#define SHIFT8(ZC, ZP, ZN, CK, VAL) do { \
        const f32x4 m0 = *(const f32x4*)(MU + (CK) * 8), m1 = *(const f32x4*)(MU + (CK) * 8 + 4); \
        const unsigned zcw[4] = {ZC.x, ZC.y, ZC.z, ZC.w}, zpw[4] = {ZP.x, ZP.y, ZP.z, ZP.w}, znw[4] = {ZN.x, ZN.y, ZN.z, ZN.w}; \
        _Pragma("unroll") for (int j = 0; j < 4; ++j) { \
          const float c0 = __uint_as_float(zcw[j] << 16), c1 = __uint_as_float(zcw[j] & 0xffff0000u); \
          const float p0 = __uint_as_float(zpw[j] << 16), p1 = __uint_as_float(zpw[j] & 0xffff0000u); \
          const float n0 = __uint_as_float(znw[j] << 16), n1 = __uint_as_float(znw[j] & 0xffff0000u); \
          const float mm0 = (j < 2) ? m0[2 * j] : m1[2 * j - 4], mm1 = (j < 2) ? m0[2 * j + 1] : m1[2 * j - 3]; \
          VAL[2 * j] = c0 + mm0 * (0.5f * (p0 + n0) - c0); \
          VAL[2 * j + 1] = c1 + mm1 * (0.5f * (p1 + n1) - c1); } } while (0)
      {
        float val[8];
        SHIFT8(pc0, pp0, pn0, ckA, val);
        float* dst = (ckA < 8) ? Rv : ((ckA < 16) ? KMv : Vv);
        *(f32x4*)(dst + tokA * 64 + (ckA & 7) * 8) = (f32x4){val[0], val[1], val[2], val[3]};
        *(f32x4*)(dst + tokA * 64 + (ckA & 7) * 8 + 4) = (f32x4){val[4], val[5], val[6], val[7]};
      }
      if (wid < 4) {
        float val[8];
        SHIFT8(pc1, pp1, pn1, ckB, val);
        float* dst = (ckB < 8) ? Rv : ((ckB < 16) ? KMv : Vv);
        *(f32x4*)(dst + tokB * 64 + (ckB & 7) * 8) = (f32x4){val[0], val[1], val[2], val[3]};
        *(f32x4*)(dst + tokB * 64 + (ckB & 7) * 8 + 4) = (f32x4){val[4], val[5], val[6], val[7]};
      }
      if (wid < 4) {
        float val[8];
        SHIFT8(pc2, pp2, pn2, ckC, val);
        uint4 o; o.x = pk_bf16(tanhf_(val[0]), tanhf_(val[1])); o.y = pk_bf16(tanhf_(val[2]), tanhf_(val[3]));
        o.z = pk_bf16(tanhf_(val[4]), tanhf_(val[5])); o.w = pk_bf16(tanhf_(val[6]), tanhf_(val[7]));
        *(uint4*)(TW + tokC * 72 + (ckC - 24) * 8) = o;
      } else if (wid < 6) {
        float val[8];
        SHIFT8(pc2, pp2, pn2, ckC, val);
        uint4 o; o.x = pk_bf16(val[0], val[1]); o.y = pk_bf16(val[2], val[3]); o.z = pk_bf16(val[4], val[5]); o.w = pk_bf16(val[6], val[7]);
        *(uint4*)(AL + tokC * 40 + (ckC - 32) * 8) = o;
      }
#undef SHIFT8
      if (ci + 1 < 64) SCAN_LOAD_ALL(ci + 1);
      __syncthreads();
      {
        const int mt = wid >> 2, nt = wid & 3;
        f32x4 accw = (f32x4){0.f, 0.f, 0.f, 0.f}, acca = (f32x4){0.f, 0.f, 0.f, 0.f};
#pragma unroll
        for (int ks = 0; ks < 2; ++ks) {
          const bf16x8 a_op = *(const bf16x8*)(TW + (mt * 16 + fr) * 72 + ks * 32 + fq * 8);
          const bf16x8 b_op = *(const bf16x8*)(WupT + (nt * 16 + fr) * 72 + ks * 32 + fq * 8);
          accw = __builtin_amdgcn_mfma_f32_16x16x32_bf16(a_op, b_op, accw, 0, 0, 0);
        }
        {
          const bf16x8 a_op = *(const bf16x8*)(AL + (mt * 16 + fr) * 40 + fq * 8);
          const bf16x8 b_op = *(const bf16x8*)(AupT + (nt * 16 + fr) * 40 + fq * 8);
          acca = __builtin_amdgcn_mfma_f32_16x16x32_bf16(a_op, b_op, acca, 0, 0, 0);
        }
#pragma unroll
        for (int r = 0; r < 4; ++r) {
          WP[(mt * 16 + fq * 4 + r) * 64 + nt * 16 + fr] = accw[r];
          AP[(mt * 16 + fq * 4 + r) * 64 + nt * 16 + fr] = acca[r];
        }
      }
      __syncthreads();
      {
        const f32x4 wp = *(const f32x4*)(WP + ptok * 64 + pc4);
        const f32x4 ap = *(const f32x4*)(AP + ptok * 64 + pc4);
        const f32x4 kr = *(const f32x4*)(KMv + ptok * 64 + pc4);
        const f32x4 rv = *(const f32x4*)(Rv + ptok * 64 + pc4);
        f32x2 kkv[2], av[2], lwv[2], kmv[2];
        f32x2 ssq2 = (f32x2){0.f, 0.f}, bet2 = (f32x2){0.f, 0.f};
#pragma unroll
        for (int hp = 0; hp < 2; ++hp) {
          const f32x2 wx = (f32x2){w0v[2 * hp], w0v[2 * hp + 1]} + (f32x2){wp[2 * hp], wp[2 * hp + 1]};
          const f32x2 ax = (f32x2){a0v[2 * hp], a0v[2 * hp + 1]} + (f32x2){ap[2 * hp], ap[2 * hp + 1]};
          f32x2 sg, sa_;
          sg[0] = sigmoidf_(wx[0]); sg[1] = sigmoidf_(wx[1]);
          sa_[0] = sigmoidf_(ax[0]); sa_[1] = sigmoidf_(ax[1]);
          lwv[hp] = sg * (-0.60653065971f);
          av[hp] = sa_;
          const f32x2 k2 = (f32x2){kr[2 * hp], kr[2 * hp + 1]};
          kkv[hp] = k2 * (f32x2){kkc[2 * hp], kkc[2 * hp + 1]};
          ssq2 += kkv[hp] * kkv[hp];
          kmv[hp] = k2 * ((sa_ - 1.f) * (f32x2){kac[2 * hp], kac[2 * hp + 1]} + 1.f);
          bet2 += (f32x2){rv[2 * hp], rv[2 * hp + 1]} * kmv[hp] * (f32x2){rkc[2 * hp], rkc[2 * hp + 1]};
        }
        float ssq = ssq2[0] + ssq2[1], bet = bet2[0] + bet2[1];
        for (int m = 0; m < 1; ++m) {
          ssq += dppf<0xB1>(ssq); bet += dppf<0xB1>(bet);
          ssq += dppf<0x4E>(ssq); bet += dppf<0x4E>(bet);
          ssq += dppf<0x141>(ssq); bet += dppf<0x141>(bet);
          ssq += dppf<0x140>(ssq); bet += dppf<0x140>(bet);
        }
        const float rn = rsqrtf(ssq + 1e-12f);
        const f32x2 kk0 = kkv[0] * rn, kk1 = kkv[1] * rn;
        const f32x2 b0 = kk0 * av[0], b1 = kk1 * av[1];
        *(f32x4*)(KKv + ptok * 64 + pc4) = (f32x4){kk0[0], kk0[1], kk1[0], kk1[1]};
        *(f32x4*)(Bv + ptok * 64 + pc4) = (f32x4){b0[0], b0[1], b1[0], b1[1]};
        *(f32x4*)(KMv + ptok * 64 + pc4) = (f32x4){kmv[0][0], kmv[0][1], kmv[1][0], kmv[1][1]};
        *(f32x4*)(LWv + ptok * 64 + pc4) = (f32x4){lwv[0][0], lwv[0][1], lwv[1][0], lwv[1][1]};
        if ((tid & 15) == 0) {
          const int s = ci * 32 + ptok; const int t = d ? (T_ - 1 - s) : s;
          p.beta[(((size_t)d * NB_ + b) * T_ + t) * 8 + h] = bet;
        }
      }
      asm volatile("s_waitcnt lgkmcnt(0)" ::: "memory");
      __builtin_amdgcn_wave_barrier();
      {
        const int c = lane, tg = wid;
        float lw[4], cs[4];
#pragma unroll
        for (int j = 0; j < 4; ++j) lw[j] = LWv[(4 * tg + j) * 64 + c];
        cs[0] = lw[0]; cs[1] = cs[0] + lw[1]; cs[2] = cs[1] + lw[2]; cs[3] = cs[2] + lw[3];
        GT[tg * 64 + c] = cs[3];
        __syncthreads();
        float offs = 0.f, tot = 0.f;
#pragma unroll
        for (int g2 = 0; g2 < 8; ++g2) { const float gv = GT[g2 * 64 + c]; tot += gv; if (g2 < tg) offs += gv; }
        float bt4[4], kt4[4], vt4[4];
        const float etot = __expf(tot);
        float epv = __expf(offs);
#pragma unroll
        for (int j = 0; j < 4; ++j) {
          const int t = 4 * tg + j;
          const float lg = offs + cs[j];
          const float kap = KKv[t * 64 + c], bb = Bv[t * 64 + c], km = KMv[t * 64 + c], rr = Rv[t * 64 + c];
          vt4[j] = Vv[t * 64 + c];
          const float ep = __expf(lg), em = __builtin_amdgcn_rcpf(ep), ec = etot * em;
          AH[t * 72 + c] = f2bf(-kap * epv);
          BH[t * 72 + c] = f2bf(bb * em);
          KH[t * 72 + c] = f2bf(km * em);
          RH[t * 72 + c] = f2bf(rr * ep);
          bt4[j] = bb * ec; kt4[j] = km * ec;
          epv = ep;
        }
        *(uint2*)(BTT + c * 40 + 4 * tg) = make_uint2(pk_bf16(bt4[0], bt4[1]), pk_bf16(bt4[2], bt4[3]));
        *(uint2*)(KTT + c * 40 + 4 * tg) = make_uint2(pk_bf16(kt4[0], kt4[1]), pk_bf16(kt4[2], kt4[3]));
        *(uint2*)(VT + c * 40 + 4 * tg) = make_uint2(pk_bf16(vt4[0], vt4[1]), pk_bf16(vt4[2], vt4[3]));
        if (tg == 0) GC[c] = etot;
      }
      __syncthreads();
      {
        const int mtx = wid >> 1, it = wid & 1;
        const bf16_t* Pi = (mtx & 1) ? KH : BH;
        const bf16_t* Qt = (mtx < 2) ? AH : RH;
        const bf16x8 pa0 = *(const bf16x8*)(Pi + (it * 16 + fr) * 72 + fq * 8);
        const bf16x8 pa1 = *(const bf16x8*)(Pi + (it * 16 + fr) * 72 + 32 + fq * 8);
#pragma unroll
        for (int tt = 0; tt < 2; ++tt) {
          f32x4 acc = (f32x4){0.f, 0.f, 0.f, 0.f};
          const bf16x8 qb0 = *(const bf16x8*)(Qt + (tt * 16 + fr) * 72 + fq * 8);
          const bf16x8 qb1 = *(const bf16x8*)(Qt + (tt * 16 + fr) * 72 + 32 + fq * 8);
          acc = __builtin_amdgcn_mfma_f32_16x16x32_bf16(pa0, qb0, acc, 0, 0, 0);
          acc = __builtin_amdgcn_mfma_f32_16x16x32_bf16(pa1, qb1, acc, 0, 0, 0);
          const int t = tt * 16 + fr, i0 = it * 16 + fq * 4;
          const int lim = (mtx < 2) ? (t - 1) : t;
          f32x4 mk;
#pragma unroll
          for (int r = 0; r < 4; ++r) mk[r] = (i0 + r <= lim) ? acc[r] : 0.f;
          if (mtx == 0) {
#pragma unroll
            for (int r = 0; r < 4; ++r) { const int i = i0 + r; MAB[t * 32 + (i & 3) * 8 + (i >> 2)] = mk[r]; }
          }
          else {
            bf16_t* Mo = (mtx == 1) ? MAK : ((mtx == 2) ? MRB : MRK);
            *(uint2*)(Mo + t * 40 + i0) = make_uint2(pk_bf16(mk[0], mk[1]), pk_bf16(mk[2], mk[3]));
          }
        }
      }
      const int vt_ = wid >> 1, tt_ = wid & 1;
      f32x4 accY = (f32x4){0.f, 0.f, 0.f, 0.f}, accW = (f32x4){0.f, 0.f, 0.f, 0.f};
      {
        const bf16x8 s0 = *(const bf16x8*)(SB + (vt_ * 16 + fr) * 72 + fq * 8);
        const bf16x8 s1 = *(const bf16x8*)(SB + (vt_ * 16 + fr) * 72 + 32 + fq * 8);
        const bf16x8 a0 = *(const bf16x8*)(AH + (tt_ * 16 + fr) * 72 + fq * 8);
        const bf16x8 a1 = *(const bf16x8*)(AH + (tt_ * 16 + fr) * 72 + 32 + fq * 8);
        const bf16x8 r0 = *(const bf16x8*)(RH + (tt_ * 16 + fr) * 72 + fq * 8);
        const bf16x8 r1 = *(const bf16x8*)(RH + (tt_ * 16 + fr) * 72 + 32 + fq * 8);
        accW = __builtin_amdgcn_mfma_f32_16x16x32_bf16(s0, a0, accW, 0, 0, 0);
        accW = __builtin_amdgcn_mfma_f32_16x16x32_bf16(s1, a1, accW, 0, 0, 0);
        accY = __builtin_amdgcn_mfma_f32_16x16x32_bf16(s0, r0, accY, 0, 0, 0);
        accY = __builtin_amdgcn_mfma_f32_16x16x32_bf16(s1, r1, accY, 0, 0, 0);
      }
      __syncthreads();
      {
        const bf16x8 vv = *(const bf16x8*)(VT + (vt_ * 16 + fr) * 40 + fq * 8);
        const bf16x8 mak = *(const bf16x8*)(MAK + (tt_ * 16 + fr) * 40 + fq * 8);
        const bf16x8 mrk = *(const bf16x8*)(MRK + (tt_ * 16 + fr) * 40 + fq * 8);
        accW = __builtin_amdgcn_mfma_f32_16x16x32_bf16(vv, mak, accW, 0, 0, 0);
        accY = __builtin_amdgcn_mfma_f32_16x16x32_bf16(vv, mrk, accY, 0, 0, 0);
        *(f32x4*)(Wb + (tt_ * 16 + fr) * 68 + vt_ * 16 + fq * 4) = accW;
      }
      __syncthreads();
      if (wid < 4) {
        const int q = lane & 3, v = wid * 16 + (lane >> 2);
        f32x2 u01 = (f32x2){0.f, 0.f}, u23 = (f32x2){0.f, 0.f}, u45 = (f32x2){0.f, 0.f}, u67 = (f32x2){0.f, 0.f};
        f32x4 Am0[4], Am1[4], Bm0[4], Bm1[4]; float Aw[4], Bw[4];
#define P6_LOAD(X, T0) do { _Pragma("unroll") for (int s_ = 0; s_ < 4; ++s_) { const int t_ = (T0) + s_; \
          X##m0[s_] = *(const f32x4*)(MAB + t_ * 32 + q * 8); X##m1[s_] = *(const f32x4*)(MAB + t_ * 32 + q * 8 + 4); X##w[s_] = Wb[t_ * 68 + v]; } } while (0)
#define P6_STEPS(X, T0) do { _Pragma("unroll") for (int s_ = 0; s_ < 4; ++s_) { const int t_ = (T0) + s_; \
          f32x2 pa_ = u01 * (f32x2){X##m0[s_][0], X##m0[s_][1]} + u45 * (f32x2){X##m1[s_][0], X##m1[s_][1]}; \
          f32x2 pb_ = u23 * (f32x2){X##m0[s_][2], X##m0[s_][3]} + u67 * (f32x2){X##m1[s_][2], X##m1[s_][3]}; \
          pa_ += pb_; \
          float part = pa_[0] + pa_[1]; \
          part += dppf<0xB1>(part); part += dppf<0x4E>(part); \
          const float ut = X##w[s_] + part; \
          const bool mine = (q == (t_ & 3)); const int j_ = t_ >> 2; \
          if (j_ == 0) u01[0] = mine ? ut : u01[0]; else if (j_ == 1) u01[1] = mine ? ut : u01[1]; \
          else if (j_ == 2) u23[0] = mine ? ut : u23[0]; else if (j_ == 3) u23[1] = mine ? ut : u23[1]; \
          else if (j_ == 4) u45[0] = mine ? ut : u45[0]; else if (j_ == 5) u45[1] = mine ? ut : u45[1]; \
          else if (j_ == 6) u67[0] = mine ? ut : u67[0]; else u67[1] = mine ? ut : u67[1]; } } while (0)
        P6_LOAD(A, 0);
#pragma unroll
        for (int blk = 0; blk < 8; blk += 2) {
          P6_LOAD(B, (blk + 1) * 4);
          P6_STEPS(A, blk * 4);
          if (blk + 2 < 8) P6_LOAD(A, (blk + 2) * 4);
          P6_STEPS(B, (blk + 1) * 4);
        }
#undef P6_LOAD
#undef P6_STEPS
        bf16_t* up = UT + v * 40 + q;
        up[0] = f2bf(u01[0]); up[4] = f2bf(u01[1]); up[8] = f2bf(u23[0]); up[12] = f2bf(u23[1]);
        up[16] = f2bf(u45[0]); up[20] = f2bf(u45[1]); up[24] = f2bf(u67[0]); up[28] = f2bf(u67[1]);
      }
      __syncthreads();
      {
        const bf16x8 uu = *(const bf16x8*)(UT + (vt_ * 16 + fr) * 40 + fq * 8);
        const bf16x8 mrb = *(const bf16x8*)(MRB + (tt_ * 16 + fr) * 40 + fq * 8);
        accY = __builtin_amdgcn_mfma_f32_16x16x32_bf16(uu, mrb, accY, 0, 0, 0);
        const int s = ci * 32 + tt_ * 16 + fr; const int t = d ? (T_ - 1 - s) : s;
        *(uint2*)(p.ys + ((size_t)d * NTOK + (size_t)b * T_ + t) * 512 + h * 64 + vt_ * 16 + fq * 4) = make_uint2(pk_bf16(accY[0], accY[1]), pk_bf16(accY[2], accY[3]));
        const int kt_ = wid >> 1;
        const f32x4 gc = *(const f32x4*)(GC + kt_ * 16 + fq * 4);
        const bf16x8 bt = *(const bf16x8*)(BTT + (kt_ * 16 + fr) * 40 + fq * 8);
        const bf16x8 ktv = *(const bf16x8*)(KTT + (kt_ * 16 + fr) * 40 + fq * 8);
#pragma unroll
        for (int j = 0; j < 2; ++j) {
          const int v2 = (wid & 1) * 2 + j;
          const bf16x8 u2 = *(const bf16x8*)(UT + (v2 * 16 + fr) * 40 + fq * 8);
          const bf16x8 vv2 = *(const bf16x8*)(VT + (v2 * 16 + fr) * 40 + fq * 8);
          accS[j] = accS[j] * gc;
          accS[j] = __builtin_amdgcn_mfma_f32_16x16x32_bf16(bt, u2, accS[j], 0, 0, 0);
          accS[j] = __builtin_amdgcn_mfma_f32_16x16x32_bf16(ktv, vv2, accS[j], 0, 0, 0);
          *(uint2*)(SB + (v2 * 16 + fr) * 72 + kt_ * 16 + fq * 4) = make_uint2(pk_bf16(accS[j][0], accS[j][1]), pk_bf16(accS[j][2], accS[j][3]));
        }
      }
      __syncthreads();
    }
  }
#undef SCAN_LD
#undef SCAN_ITEMS
#undef SCAN_LOAD_ALL
}

__device__ __forceinline__ void phase_rwkv_fin(const Params& p) {
  const int lane = threadIdx.x & 63, wid = threadIdx.x >> 6;
  const int ch0 = lane * 8, h = lane >> 3;
  float gng[8], gnb[8], muv[8];
#pragma unroll
  for (int j = 0; j < 8; ++j) { gng[j] = p.gn_g[ch0 + j]; gnb[j] = p.gn_b[ch0 + j]; muv[j] = p.mu[1024 + ch0 + j]; }
  const int stride = gridDim.x * 8;
  for (int tok0 = blockIdx.x * 8 + wid; tok0 < NTOK; tok0 += 2 * stride) {
    f32x4 ya0[2], ya1[2], yb0[2], yb1[2]; uint4 zc4[2], zp4[2], zn4[2], g4[2]; float bet[2];
#pragma unroll
    for (int r = 0; r < 2; ++r) {
      const int tok = tok0 + r * stride;
      if (tok < NTOK) {
        const int b = tok >> 11, t = tok & 2047;
        {
          const uint4 qa = *(const uint4*)(p.ys + (size_t)tok * 512 + ch0), qb = *(const uint4*)(p.ys + ((size_t)NTOK + tok) * 512 + ch0);
          ya0[r] = (f32x4){__uint_as_float(qa.x << 16), __uint_as_float(qa.x & 0xffff0000u), __uint_as_float(qa.y << 16), __uint_as_float(qa.y & 0xffff0000u)};
          ya1[r] = (f32x4){__uint_as_float(qa.z << 16), __uint_as_float(qa.z & 0xffff0000u), __uint_as_float(qa.w << 16), __uint_as_float(qa.w & 0xffff0000u)};
          yb0[r] = (f32x4){__uint_as_float(qb.x << 16), __uint_as_float(qb.x & 0xffff0000u), __uint_as_float(qb.y << 16), __uint_as_float(qb.y & 0xffff0000u)};
          yb1[r] = (f32x4){__uint_as_float(qb.z << 16), __uint_as_float(qb.z & 0xffff0000u), __uint_as_float(qb.w << 16), __uint_as_float(qb.w & 0xffff0000u)};
        }
        const bf16_t* zp_ = p.proj + (size_t)tok * N0P + 2560 + ch0;
        zc4[r] = *(const uint4*)zp_;
        zp4[r] = make_uint4(0u, 0u, 0u, 0u); zn4[r] = make_uint4(0u, 0u, 0u, 0u);
        if (t > 0) zp4[r] = *(const uint4*)(zp_ - N0P);
        if (t < T_ - 1) zn4[r] = *(const uint4*)(zp_ + N0P);
        g4[r] = *(const uint4*)(p.proj + (size_t)tok * N0P + 3264 + ch0);
        bet[r] = 0.5f * (p.beta[((size_t)b * T_ + t) * 8 + h] + p.beta[(((size_t)NB_ + b) * T_ + t) * 8 + h]);
      }
    }
#pragma unroll
    for (int r = 0; r < 2; ++r) {
      const int tok = tok0 + r * stride;
      if (tok < NTOK) {
        float y[8];
#pragma unroll
        for (int j = 0; j < 4; ++j) { y[j] = ya0[r][j] + yb0[r][j]; y[4 + j] = ya1[r][j] + yb1[r][j]; }
        float sm = 0.f;
#pragma unroll
        for (int j = 0; j < 8; ++j) sm += y[j];
        sm += dppf0<0xB1>(sm); sm += dppf0<0x4E>(sm); sm += dppf0<0x141>(sm);
        const float mean = sm * (1.f / 64.f);
        float sq = 0.f;
#pragma unroll
        for (int j = 0; j < 8; ++j) { y[j] -= mean; sq += y[j] * y[j]; }
        sq += dppf0<0xB1>(sq); sq += dppf0<0x4E>(sq); sq += dppf0<0x141>(sq);
        const float rstd = rsqrtf(sq * (1.f / 64.f) + 64e-5f);
        const unsigned zcw[4] = {zc4[r].x, zc4[r].y, zc4[r].z, zc4[r].w}, zpw[4] = {zp4[r].x, zp4[r].y, zp4[r].z, zp4[r].w};
        const unsigned znw[4] = {zn4[r].x, zn4[r].y, zn4[r].z, zn4[r].w}, gw[4] = {g4[r].x, g4[r].y, g4[r].z, g4[r].w};
        float o[8];
#pragma unroll
        for (int j = 0; j < 4; ++j) {
#pragma unroll
          for (int e = 0; e < 2; ++e) {
            const int jj = 2 * j + e;
            const float zc = e ? __uint_as_float(zcw[j] & 0xffff0000u) : __uint_as_float(zcw[j] << 16);
            const float zp = e ? __uint_as_float(zpw[j] & 0xffff0000u) : __uint_as_float(zpw[j] << 16);
            const float zn = e ? __uint_as_float(znw[j] & 0xffff0000u) : __uint_as_float(znw[j] << 16);
            const float g = e ? __uint_as_float(gw[j] & 0xffff0000u) : __uint_as_float(gw[j] << 16);
            const float vs = zc + muv[jj] * (0.5f * (zp + zn) - zc);
            const float yn = y[jj] * rstd * gng[jj] + gnb[jj];
            o[jj] = (yn + bet[r] * vs) * siluf_(g);
          }
        }
        *(uint4*)(p.ycat + (size_t)tok * DM + 512 + ch0) = make_uint4(pk_bf16(o[0], o[1]), pk_bf16(o[2], o[3]), pk_bf16(o[4], o[5]), pk_bf16(o[6], o[7]));
      }
    }
  }
}

template <bool XBF>
__device__ __forceinline__ void phase_ln(const void* xin_, const bf16_t* hb, float* yout, const float* __restrict__ g, const float* __restrict__ bb, bf16_t* ob) {
  const float* xin = (const float*)xin_; const bf16_t* xinb = (const bf16_t*)xin_;
  const int lane = threadIdx.x & 63, wid = threadIdx.x >> 6;
  const int stride = gridDim.x * 8;
  f32x4 gg[4], b4[4];
#pragma unroll
  for (int i = 0; i < 2; ++i) { const int c = lane * 8 + 512 * i; gg[2 * i] = *(const f32x4*)(g + c); gg[2 * i + 1] = *(const f32x4*)(g + c + 4); b4[2 * i] = *(const f32x4*)(bb + c); b4[2 * i + 1] = *(const f32x4*)(bb + c + 4); }
  for (int row0 = blockIdx.x * 8 + wid; row0 < NTOK; row0 += 2 * stride) {
    f32x4 xv[2][4]; uint4 hv[2][2];
#pragma unroll
    for (int r = 0; r < 2; ++r) {
      const int row = row0 + r * stride;
      if (row < NTOK) {
#pragma unroll
        for (int i = 0; i < 2; ++i) {
          const int c = lane * 8 + 512 * i;
          if (XBF) {
            const uint4 xq = *(const uint4*)(xinb + (size_t)row * DM + c);
            xv[r][2 * i] = (f32x4){__uint_as_float(xq.x << 16), __uint_as_float(xq.x & 0xffff0000u), __uint_as_float(xq.y << 16), __uint_as_float(xq.y & 0xffff0000u)};
            xv[r][2 * i + 1] = (f32x4){__uint_as_float(xq.z << 16), __uint_as_float(xq.z & 0xffff0000u), __uint_as_float(xq.w << 16), __uint_as_float(xq.w & 0xffff0000u)};
          } else {
            xv[r][2 * i] = *(const f32x4*)(xin + (size_t)row * DM + c); xv[r][2 * i + 1] = *(const f32x4*)(xin + (size_t)row * DM + c + 4);
          }
          hv[r][i] = *(const uint4*)(hb + (size_t)row * DM + c);
        }
      }
    }
#pragma unroll
    for (int r = 0; r < 2; ++r) {
      const int row = row0 + r * stride;
      if (row < NTOK) {
        float v[16]; float s = 0.f;
#pragma unroll
        for (int i = 0; i < 2; ++i) {
          const unsigned hw[4] = {hv[r][i].x, hv[r][i].y, hv[r][i].z, hv[r][i].w};
#pragma unroll
          for (int j = 0; j < 4; ++j) {
            const float xa = (j < 2) ? xv[r][2 * i][2 * j] : xv[r][2 * i + 1][2 * j - 4], xb2 = (j < 2) ? xv[r][2 * i][2 * j + 1] : xv[r][2 * i + 1][2 * j - 3];
            v[8 * i + 2 * j] = ALPHA * xa + __uint_as_float(hw[j] << 16);
            v[8 * i + 2 * j + 1] = ALPHA * xb2 + __uint_as_float(hw[j] & 0xffff0000u);
            s += v[8 * i + 2 * j] + v[8 * i + 2 * j + 1];
          }
        }
        const float mean = wave_sum(s) * (1.f / 1024.f);
        float q = 0.f;
#pragma unroll
        for (int i = 0; i < 16; ++i) { v[i] -= mean; q += v[i] * v[i]; }
        const float rstd = rsqrtf(wave_sum(q) * (1.f / 1024.f) + 1e-5f);
#pragma unroll
        for (int i = 0; i < 2; ++i) {
          const int c = lane * 8 + 512 * i;
          f32x4 o0, o1;
#pragma unroll
          for (int j = 0; j < 4; ++j) { o0[j] = v[8 * i + j] * rstd * gg[2 * i][j] + b4[2 * i][j]; o1[j] = v[8 * i + 4 + j] * rstd * gg[2 * i + 1][j] + b4[2 * i + 1][j]; }
          if (yout) { *(f32x4*)(yout + (size_t)row * DM + c) = o0; *(f32x4*)(yout + (size_t)row * DM + c + 4) = o1; }
          if (ob) *(uint4*)(ob + (size_t)row * DM + c) = make_uint4(pk_bf16(o0[0], o0[1]), pk_bf16(o0[2], o0[3]), pk_bf16(o1[0], o1[1]), pk_bf16(o1[2], o1[3]));
        }
      }
    }
  }
}


__device__ __forceinline__ void phase_lr(const Params& p, char* smem) {
  bf16_t* WL = (bf16_t*)smem;
  const int tid = threadIdx.x, lane = tid & 63, wid = tid >> 6, fr = lane & 15, fq = lane >> 4;
#pragma unroll
  for (int i = 0; i < 8; ++i) {
    const int q = tid + 512 * i; const int n = q >> 7, ck = q & 127;
    *(uint4*)(WL + n * 1032 + ck * 8) = *(const uint4*)(p.wt1 + (size_t)(3072 + n) * DM + ck * 8);
  }
  __syncthreads();
  for (int tile = blockIdx.x * 8 + wid; tile < NTOK / 16; tile += gridDim.x * 8) {
    const bf16_t* ap = p.x1k + (size_t)(tile * 16 + fr) * DM + fq * 8;
    const bf16_t* w0p = WL + fr * 1032 + fq * 8;
    const bf16_t* w1p = WL + (16 + fr) * 1032 + fq * 8;
    f32x4 acc0 = (f32x4){0.f, 0.f, 0.f, 0.f}, acc1 = (f32x4){0.f, 0.f, 0.f, 0.f};
#pragma unroll 16
    for (int ks = 0; ks < 32; ++ks) {
      const bf16x8 a = *(const bf16x8*)(ap + ks * 32);
      const bf16x8 w0 = *(const bf16x8*)(w0p + ks * 32), w1 = *(const bf16x8*)(w1p + ks * 32);
      acc0 = __builtin_amdgcn_mfma_f32_16x16x32_bf16(w0, a, acc0, 0, 0, 0);
      acc1 = __builtin_amdgcn_mfma_f32_16x16x32_bf16(w1, a, acc1, 0, 0, 0);
    }
    bf16_t* op = p.lrb + (size_t)(tile * 16 + fr) * 32 + fq * 4;
    *(uint2*)op = make_uint2(pk_bf16(acc0[0], acc0[1]), pk_bf16(acc0[2], acc0[3]));
    *(uint2*)(op + 16) = make_uint2(pk_bf16(acc1[0], acc1[1]), pk_bf16(acc1[2], acc1[3]));
  }
  __syncthreads();
}

__device__ __forceinline__ int swz64(int row, int ch) { return row * 64 + ((ch ^ ((row >> 1) & 7)) << 3); }

__device__ __forceinline__ void phase_gla(const Params& p, char* smem) {
  bf16_t* QT = (bf16_t*)smem;
  bf16_t* KT = QT + 64 * 136;
  bf16_t* KRT = KT + 64 * 136;
  bf16_t* VT = KRT + 128 * 72;
  bf16_t* PP = VT + 128 * 72;
  bf16_t* ST = PP + 64 * 72;
  float* LR = (float*)(ST + 128 * 136);
  float* GT = LR + 1024;
  float* DEC = GT + 1024;
  float* LR1 = DEC + 128;
  const int tid = threadIdx.x, lane = tid & 63, wid = tid >> 6;
  const int fr = lane & 15, fq = lane >> 4;
  const int c2 = tid & 63, tg = tid >> 6;
  for (int item = blockIdx.x; item < 256; item += gridDim.x) {
    const int d = item >> 7, b = (item >> 3) & 15, h = (item >> 1) & 3, vh = item & 1;
    __syncthreads();
    for (int i = tid; i < 128 * 136 / 2; i += NTHR) ((unsigned*)ST)[i] = 0u;
    f32x2 gup2[16];
#pragma unroll
    for (int r = 0; r < 16; ++r) gup2[r] = *(const f32x2*)(p.g_up + ((size_t)d * 16 + r) * 512 + h * 128 + 2 * c2);
    const f32x2 gb2 = *(const f32x2*)(p.g_bias + d * 512 + h * 128 + 2 * c2);
    f32x4 accs[8];
#pragma unroll
    for (int i = 0; i < 8; ++i) accs[i] = (f32x4){0.f, 0.f, 0.f, 0.f};
    const bf16_t* pbase = p.proj + (size_t)b * T_ * N1P;
    bf16_t lrr[2]; unsigned qr[8], kr[8], vr[8];
#define GLA_LOAD_RAW(CI) do { \
      _Pragma("unroll") for (int i2_ = 0; i2_ < 2; ++i2_) { \
        const int e_ = tid + 512 * i2_; const int tok_ = e_ >> 4, r_ = e_ & 15; \
        const int s_ = (CI) * 64 + tok_; const int t_ = d ? (T_ - 1 - s_) : s_; \
        lrr[i2_] = p.lrb[((size_t)b * T_ + t_) * 32 + d * 16 + r_]; } \
      _Pragma("unroll") for (int ii_ = 0; ii_ < 8; ++ii_) { \
        const int s_ = (CI) * 64 + tg * 8 + ii_; const int t_ = d ? (T_ - 1 - s_) : s_; \
        const bf16_t* rowp_ = pbase + (size_t)t_ * N1P; \
        qr[ii_] = *(const unsigned*)(rowp_ + h * 128 + 2 * c2); kr[ii_] = *(const unsigned*)(rowp_ + 512 + h * 128 + 2 * c2); \
        vr[ii_] = *(const unsigned*)(rowp_ + 1024 + h * 256 + vh * 128 + 2 * c2); } } while (0)
    GLA_LOAD_RAW(0);
    for (int ci = 0; ci < 32; ++ci) {
#pragma unroll
      for (int i2 = 0; i2 < 2; ++i2) { const int e = tid + 512 * i2; LR[(e >> 4) * 16 + (e & 15)] = bf2f(lrr[i2]); }
      __syncthreads();
      f32x2 bl[8]; f32x2 cum = (f32x2){0.f, 0.f};
#pragma unroll
      for (int ii = 0; ii < 8; ++ii) {
        const int i = tg * 8 + ii;
        f32x2 xg = gb2;
#pragma unroll
        for (int r4 = 0; r4 < 4; ++r4) {
          const f32x4 l4 = *(const f32x4*)(LR + i * 16 + r4 * 4);
          xg += (f32x2){l4[0], l4[0]} * gup2[r4 * 4 + 0];
          xg += (f32x2){l4[1], l4[1]} * gup2[r4 * 4 + 1];
          xg += (f32x2){l4[2], l4[2]} * gup2[r4 * 4 + 2];
          xg += (f32x2){l4[3], l4[3]} * gup2[r4 * 4 + 3];
        }
        f32x2 ls;
        ls[0] = fminf(xg[0], 0.f) - 0.69314718056f * __builtin_amdgcn_logf(1.f + __expf(-fabsf(xg[0])));
        ls[1] = fminf(xg[1], 0.f) - 0.69314718056f * __builtin_amdgcn_logf(1.f + __expf(-fabsf(xg[1])));
        cum += ls * (1.f / 16.f);
        bl[ii] = cum;
      }
      *(f32x2*)(GT + (tg * 64 + c2) * 2) = cum;
      __syncthreads();
      {
        f32x2 offs = (f32x2){0.f, 0.f}, total = (f32x2){0.f, 0.f};
#pragma unroll
        for (int g2 = 0; g2 < 8; ++g2) { const f32x2 gv = *(const f32x2*)(GT + (g2 * 64 + c2) * 2); total += gv; if (g2 < tg) offs += gv; }
        f32x2 krv[8];
        f32x2 etot; etot[0] = __expf(total[0]); etot[1] = __expf(total[1]);
#pragma unroll
        for (int ii = 0; ii < 8; ++ii) {
          const int i = tg * 8 + ii;
          const f32x2 bv = bl[ii] + offs;
          f32x2 eb, ebi;
          eb[0] = __expf(bv[0]); eb[1] = __expf(bv[1]);
          ebi[0] = __builtin_amdgcn_rcpf(eb[0]); ebi[1] = __builtin_amdgcn_rcpf(eb[1]);
          const f32x2 qraw = (f32x2){__uint_as_float(qr[ii] << 16), __uint_as_float(qr[ii] & 0xffff0000u)};
          const f32x2 kraw = (f32x2){__uint_as_float(kr[ii] << 16), __uint_as_float(kr[ii] & 0xffff0000u)};
          const f32x2 qv = qraw * 0.08838834764831845f * eb;
          const f32x2 kv = kraw * ebi;
          *(unsigned*)(QT + i * 136 + 2 * c2) = pk_bf16(qv[0], qv[1]);
          *(unsigned*)(KT + i * 136 + 2 * c2) = pk_bf16(kv[0], kv[1]);
          krv[ii] = kv * etot;
        }
        *(uint4*)(KRT + swz64(2 * c2, tg)) = make_uint4(pk_bf16(krv[0][0], krv[1][0]), pk_bf16(krv[2][0], krv[3][0]), pk_bf16(krv[4][0], krv[5][0]), pk_bf16(krv[6][0], krv[7][0]));
        *(uint4*)(KRT + swz64(2 * c2 + 1, tg)) = make_uint4(pk_bf16(krv[0][1], krv[1][1]), pk_bf16(krv[2][1], krv[3][1]), pk_bf16(krv[4][1], krv[5][1]), pk_bf16(krv[6][1], krv[7][1]));
        *(uint4*)(VT + swz64(2 * c2, tg)) = make_uint4((vr[0] & 0xffffu) | (vr[1] << 16), (vr[2] & 0xffffu) | (vr[3] << 16), (vr[4] & 0xffffu) | (vr[5] << 16), (vr[6] & 0xffffu) | (vr[7] << 16));
        *(uint4*)(VT + swz64(2 * c2 + 1, tg)) = make_uint4((vr[0] >> 16) | (vr[1] & 0xffff0000u), (vr[2] >> 16) | (vr[3] & 0xffff0000u), (vr[4] >> 16) | (vr[5] & 0xffff0000u), (vr[6] >> 16) | (vr[7] & 0xffff0000u));
        if (tg == 0) *(f32x2*)(DEC + 2 * c2) = etot;
      }
      if (ci + 1 < 32) GLA_LOAD_RAW(ci + 1);
      __syncthreads();
#pragma unroll
      for (int tt = 0; tt < 2; ++tt) {
        const int tile = wid * 2 + tt; const int it = tile >> 2, jt = tile & 3;
        f32x4 acc = (f32x4){0.f, 0.f, 0.f, 0.f};
#pragma unroll
        for (int ks = 0; ks < 4; ++ks) {
          const bf16x8 a_op = *(const bf16x8*)(KT + (jt * 16 + fr) * 136 + ks * 32 + fq * 8);
          const bf16x8 b_op = *(const bf16x8*)(QT + (it * 16 + fr) * 136 + ks * 32 + fq * 8);
          acc = __builtin_amdgcn_mfma_f32_16x16x32_bf16(a_op, b_op, acc, 0, 0, 0);
        }
        const int i = it * 16 + fr, j0 = jt * 16 + fq * 4;
        const float p0 = (j0 + 0 <= i) ? acc[0] : 0.f, p1 = (j0 + 1 <= i) ? acc[1] : 0.f;
        const float p2 = (j0 + 2 <= i) ? acc[2] : 0.f, p3 = (j0 + 3 <= i) ? acc[3] : 0.f;
        uint2 o; o.x = pk_bf16(p0, p1); o.y = pk_bf16(p2, p3);
        *(uint2*)(PP + swz64(i, j0 >> 3) + (j0 & 7)) = o;
      }
      __syncthreads();
      {
        f32x4 acco[4];
#pragma unroll
        for (int mi = 0; mi < 4; ++mi) acco[mi] = (f32x4){0.f, 0.f, 0.f, 0.f};
#pragma unroll
        for (int ks = 0; ks < 2; ++ks) {
          const bf16x8 a_op = *(const bf16x8*)(VT + swz64(wid * 16 + fr, ks * 4 + fq));
#pragma unroll
          for (int mi = 0; mi < 4; ++mi) {
            const bf16x8 b_op = *(const bf16x8*)(PP + swz64(mi * 16 + fr, ks * 4 + fq));
            acco[mi] = __builtin_amdgcn_mfma_f32_16x16x32_bf16(a_op, b_op, acco[mi], 0, 0, 0);
          }
        }
#pragma unroll
        for (int ks = 0; ks < 4; ++ks) {
          const bf16x8 a_op = *(const bf16x8*)(ST + (wid * 16 + fr) * 136 + ks * 32 + fq * 8);
#pragma unroll
          for (int mi = 0; mi < 4; ++mi) {
            const bf16x8 b_op = *(const bf16x8*)(QT + (mi * 16 + fr) * 136 + ks * 32 + fq * 8);
            acco[mi] = __builtin_amdgcn_mfma_f32_16x16x32_bf16(a_op, b_op, acco[mi], 0, 0, 0);
          }
        }
#pragma unroll
        for (int mi = 0; mi < 4; ++mi) {
          const int i = mi * 16 + fr;
          const int s = ci * 64 + i; const int t = d ? (T_ - 1 - s) : s;
          uint2 o; o.x = pk_bf16(acco[mi][0], acco[mi][1]); o.y = pk_bf16(acco[mi][2], acco[mi][3]);
          *(uint2*)(p.go + ((size_t)d * NTOK + (size_t)b * T_ + t) * DM + h * 256 + vh * 128 + wid * 16 + fq * 4) = o;
        }
      }
      bf16x8 vfr[2];
#pragma unroll
      for (int ks = 0; ks < 2; ++ks) vfr[ks] = *(const bf16x8*)(VT + swz64(wid * 16 + fr, ks * 4 + fq));
#pragma unroll
      for (int ct = 0; ct < 8; ++ct) {
        const f32x4 dec = *(const f32x4*)(DEC + ct * 16 + fq * 4);
        accs[ct] = accs[ct] * dec;
#pragma unroll
        for (int ks = 0; ks < 2; ++ks) {
          const bf16x8 a_op = *(const bf16x8*)(KRT + swz64(ct * 16 + fr, ks * 4 + fq));
          accs[ct] = __builtin_amdgcn_mfma_f32_16x16x32_bf16(a_op, vfr[ks], accs[ct], 0, 0, 0);
        }
        uint2 o; o.x = pk_bf16(accs[ct][0], accs[ct][1]); o.y = pk_bf16(accs[ct][2], accs[ct][3]);
        *(uint2*)(ST + (wid * 16 + fr) * 136 + ct * 16 + fq * 4) = o;
      }
      __syncthreads();
    }
  }
}

__device__ __forceinline__ void phase_gla_fin(const Params& p) {
  const int lane = threadIdx.x & 63, wid = threadIdx.x >> 6;
  const int n0 = lane * 16;
  float ng[16];
#pragma unroll
  for (int j = 0; j < 16; ++j) ng[j] = p.norm_g[n0 + j];
  const int stride = gridDim.x * 8;
  for (int tok0 = blockIdx.x * 8 + wid; tok0 < NTOK; tok0 += 2 * stride) {
    uint4 av[2][2], bv[2][2], gv[2][2];
#pragma unroll
    for (int r = 0; r < 2; ++r) {
      const int tok = tok0 + r * stride;
      if (tok < NTOK) {
        av[r][0] = *(const uint4*)(p.go + (size_t)tok * DM + n0); av[r][1] = *(const uint4*)(p.go + (size_t)tok * DM + n0 + 8);
        bv[r][0] = *(const uint4*)(p.go + ((size_t)NTOK + tok) * DM + n0); bv[r][1] = *(const uint4*)(p.go + ((size_t)NTOK + tok) * DM + n0 + 8);
        gv[r][0] = *(const uint4*)(p.proj + (size_t)tok * N1P + 2048 + n0); gv[r][1] = *(const uint4*)(p.proj + (size_t)tok * N1P + 2048 + n0 + 8);
      }
    }
#pragma unroll
    for (int r = 0; r < 2; ++r) {
      const int tok = tok0 + r * stride;
      if (tok < NTOK) {
        const unsigned aw[8] = {av[r][0].x, av[r][0].y, av[r][0].z, av[r][0].w, av[r][1].x, av[r][1].y, av[r][1].z, av[r][1].w};
        const unsigned bw[8] = {bv[r][0].x, bv[r][0].y, bv[r][0].z, bv[r][0].w, bv[r][1].x, bv[r][1].y, bv[r][1].z, bv[r][1].w};
        const unsigned gw[8] = {gv[r][0].x, gv[r][0].y, gv[r][0].z, gv[r][0].w, gv[r][1].x, gv[r][1].y, gv[r][1].z, gv[r][1].w};
        float o[16]; float sq = 0.f;
#pragma unroll
        for (int j = 0; j < 8; ++j) {
          o[2 * j] = __uint_as_float(aw[j] << 16) + __uint_as_float(bw[j] << 16);
          o[2 * j + 1] = __uint_as_float(aw[j] & 0xffff0000u) + __uint_as_float(bw[j] & 0xffff0000u);
          sq += o[2 * j] * o[2 * j] + o[2 * j + 1] * o[2 * j + 1];
        }
        sq += dppf0<0xB1>(sq); sq += dppf0<0x4E>(sq); sq += dppf0<0x141>(sq); sq += dppf0<0x140>(sq);
        const float rs = rsqrtf(sq * (1.f / 256.f) + 1e-6f);
        unsigned ow[8];
#pragma unroll
        for (int j = 0; j < 8; ++j) {
          const float ga = __uint_as_float(gw[j] << 16), gb2 = __uint_as_float(gw[j] & 0xffff0000u);
          ow[j] = pk_bf16(o[2 * j] * rs * ng[2 * j] * siluf_(ga), o[2 * j + 1] * rs * ng[2 * j + 1] * siluf_(gb2));
        }
        *(uint4*)(p.ycat + (size_t)tok * DM + n0) = make_uint4(ow[0], ow[1], ow[2], ow[3]);
        *(uint4*)(p.ycat + (size_t)tok * DM + n0 + 8) = make_uint4(ow[4], ow[5], ow[6], ow[7]);
      }
    }
  }
}

__device__ __forceinline__ void phase_dump(const Params& p, int mode) {
  for (size_t i = (size_t)blockIdx.x * NTHR + threadIdx.x; i < (size_t)NTOK * DM; i += (size_t)gridDim.x * NTHR) {
    const size_t tok = i >> 10; const int n = (int)(i & 1023);
    float v = 0.f;
    if (mode == 1) {
      v = bf2f(p.proj[tok * N0P + n]) + bf2f(p.proj[tok * N0P + 1024 + n]) + bf2f(p.proj[tok * N0P + 2048 + n]);
      if (n < 768) v += bf2f(p.proj[tok * N0P + 3072 + n]);
    } else if (mode == 2) {
      if (n < 512) v = bf2f(p.ycat[tok * DM + n]);
      else v = bf2f(p.ys[tok * 512 + (n - 512)]) + bf2f(p.ys[((size_t)NTOK + tok) * 512 + (n - 512)]) + ((n < 520) ? p.beta[tok * 8 + (n - 512)] + p.beta[((size_t)NTOK + tok) * 8 + (n - 512)] : 0.f);
    } else if (mode == 3) {
      v = bf2f(p.ycat[tok * DM + n]);
    } else if (mode == 4) {
      v = bf2f(p.xb[i]) + bf2f(p.wt0[i % ((size_t)N0P * DM)]) + bf2f(p.wt1[i % ((size_t)N1W * DM)]) + bf2f(p.wto0[i % ((size_t)DM * DM)]) + bf2f(p.wto1[i % ((size_t)DM * DM)]);
    }
    p.out[i] = v;
  }
}

#define XB_TMO      128
#define XB_XCNT(j)  (256  + 64 * (j))
#define XB_XSUB(j)  (1280 + 64 * (j))
#define XB_XGEN(j)  (2304 + 64 * (j))
#define XB_TOP      3328
#define XB_TOPGEN   3392
#define XCD_BAR_WORDS 3456
#define XB_SPIN_CAP (1u << 18)
#define XB_LAS __attribute__((address_space(3)))
__device__ __forceinline__ unsigned xb_ld(unsigned* p)              { return __hip_atomic_load(p, __ATOMIC_RELAXED, __HIP_MEMORY_SCOPE_AGENT); }
__device__ __forceinline__ unsigned xb_add(unsigned* p, unsigned v) { return __hip_atomic_fetch_add(p, v, __ATOMIC_RELAXED, __HIP_MEMORY_SCOPE_AGENT); }
__device__ __forceinline__ unsigned xb_xcc_id() { return (unsigned)__builtin_amdgcn_s_getreg((3 << 11) | 20) & 0xFu; }
#define XB_SPIN(cond, bar) do { unsigned _sp = 0; while (cond) { __builtin_amdgcn_s_sleep(1); \
    if ((++_sp & 255u) == 0u) { if (xb_ld(&(bar)[XB_TMO])) break; if (_sp > XB_SPIN_CAP) { atomicAdd(&(bar)[XB_TMO], 1u); break; } } } } while (0)
struct XcdBarrier { unsigned* bar; unsigned x; volatile XB_LAS unsigned* st; };
__device__ __forceinline__ XcdBarrier xcd_barrier_post(unsigned* bar, volatile XB_LAS unsigned* st) {
  XcdBarrier b; b.bar = bar; b.x = xb_xcc_id(); b.st = st;
  if (threadIdx.x == 0) (void)xb_add(&bar[XB_XCNT(b.x)], 1u);
  return b;
}
__device__ __forceinline__ void xcd_barrier_complete(unsigned* bar, unsigned x, unsigned& nloc, unsigned& nx) {
  const unsigned G = gridDim.x * gridDim.y * gridDim.z;
  unsigned sum, cnt, mine, sp = 0u;
  for (;;) {
    sum = 0u; cnt = 0u; mine = 0u;
#pragma unroll
    for (unsigned j = 0; j < 16; ++j) { const unsigned c = xb_ld(&bar[XB_XCNT(j)]); sum += c; cnt += (c > 0u) ? 1u : 0u; mine = (j == x) ? c : mine; }
    if (sum == G) break;
    __builtin_amdgcn_s_sleep(1);
    if ((++sp & 255u) == 0u) { if (xb_ld(&bar[XB_TMO])) break; if (sp > XB_SPIN_CAP) { atomicAdd(&bar[XB_TMO], 1u); break; } }
  }
  nloc = mine > 0u ? mine : 1u; nx = cnt > 0u ? cnt : 1u;
}
__device__ __forceinline__ void xcd_barrier(const XcdBarrier& b) {
  asm volatile("s_waitcnt vmcnt(0)" ::: "memory");
  __syncthreads();
  if (threadIdx.x == 0) {
    unsigned* bar = b.bar;
    __builtin_amdgcn_s_waitcnt(0);
    unsigned nloc = b.st[0], nx = b.st[1];
    if (nloc == 0u) { xcd_barrier_complete(bar, b.x, nloc, nx); b.st[0] = nloc; b.st[1] = nx; }
    const unsigned old = xb_add(&bar[XB_XSUB(b.x)], 1u);
    const unsigned gen = old / nloc;
    if (old + 1u == (gen + 1u) * nloc) {
      __builtin_amdgcn_fence(__ATOMIC_RELEASE, "agent");
      asm volatile("s_waitcnt vmcnt(0)" ::: "memory");
      const unsigned og = xb_add(&bar[XB_TOP], 1u);
      const unsigned tg = og / nx;
      if (og + 1u == (tg + 1u) * nx) xb_add(&bar[XB_TOPGEN], 1u);
      else XB_SPIN(xb_ld(&bar[XB_TOPGEN]) == tg, bar);
      __builtin_amdgcn_fence(__ATOMIC_ACQUIRE, "agent");
      xb_add(&bar[XB_XGEN(b.x)], 1u);
      asm volatile("s_waitcnt vmcnt(0)" ::: "memory");
    } else {
      XB_SPIN(xb_ld(&bar[XB_XGEN(b.x)]) == gen, bar);
      __builtin_amdgcn_fence(__ATOMIC_ACQUIRE, "agent");
      asm volatile("s_waitcnt vmcnt(0)" ::: "memory");
    }
  }
  __syncthreads();
}

__global__ void __launch_bounds__(NTHR) mega(Params p) {
  __shared__ __attribute__((aligned(16))) char smem[LDS_BYTES];
  cg::grid_group grid = cg::this_grid();
  if (threadIdx.x == 0) *(uint4*)(smem + LDS_BYTES - 16) = make_uint4(0u, 0u, 0u, 0u);
  __syncthreads();
  const XcdBarrier xb = xcd_barrier_post(p.bar, (volatile XB_LAS unsigned*)(smem + LDS_BYTES - 16));
  if (p.ph_hi > 1000) grid.sync();
#define RUN_PHASE(PH, CALL) \
  if (p.ph_lo <= (PH) && (PH) <= p.ph_hi) { CALL; } \
  if (p.ph_lo <= (PH) && (PH) < p.ph_hi) xcd_barrier(xb);
  RUN_PHASE(0, phase_prep(p, smem))
  RUN_PHASE(1, gemm_run(p.xb, p.wt0, N0P, pg8::EpiBf16{p.proj, N0P}, smem))
  RUN_PHASE(2, phase_conv(p, smem); phase_scan(p, smem))
  RUN_PHASE(3, phase_rwkv_fin(p))
  RUN_PHASE(4, gemm_run(p.ycat, p.wto0, DM, pg8::EpiBf16{p.hb, DM}, smem))
  RUN_PHASE(5, phase_ln<true>(p.xb, p.hb, nullptr, p.ln0_g, p.ln0_b, p.x1k))
  RUN_PHASE(6, gemm_run(p.x1k, p.wt1, N1P, pg8::EpiBf16{p.proj, N1P}, smem); phase_lr(p, smem))
  RUN_PHASE(7, phase_gla(p, smem))
  RUN_PHASE(8, phase_gla_fin(p))
  RUN_PHASE(9, gemm_run(p.ycat, p.wto1, DM, pg8::EpiBf16{p.hb, DM}, smem))
  RUN_PHASE(10, phase_ln<true>(p.x1k, p.hb, p.out, p.ln1_g, p.ln1_b, nullptr))
  RUN_PHASE(11, phase_dump(p, DUMPMODE))
}

extern "C" void kernel_launch(void* const* d_in, const int* in_sizes, int n_in, void* d_out, int out_size,
                              void* d_ws, size_t ws_size, hipStream_t stream) {
  Params p{};
  p.x = (const float*)d_in[0]; p.w_in0 = (const float*)d_in[1]; p.conv_w = (const float*)d_in[2]; p.conv_b = (const float*)d_in[3];
  p.conv_ln_g = (const float*)d_in[4]; p.conv_ln_b = (const float*)d_in[5]; p.mu = (const float*)d_in[6]; p.w0 = (const float*)d_in[7];
  p.w_up = (const float*)d_in[8]; p.a0 = (const float*)d_in[9]; p.a_up = (const float*)d_in[10]; p.k_k = (const float*)d_in[11];
  p.k_a = (const float*)d_in[12]; p.r_k = (const float*)d_in[13]; p.gn_g = (const float*)d_in[14]; p.gn_b = (const float*)d_in[15];
  p.w_out0 = (const float*)d_in[16]; p.ln0_g = (const float*)d_in[17]; p.ln0_b = (const float*)d_in[18];
  p.w_in1 = (const float*)d_in[19]; p.g_up = (const float*)d_in[20]; p.g_bias = (const float*)d_in[21]; p.norm_g = (const float*)d_in[22];
  p.w_out1 = (const float*)d_in[23]; p.ln1_g = (const float*)d_in[24]; p.ln1_b = (const float*)d_in[25];
  p.out = (float*)d_out;
  char* ws = (char*)d_ws;
  size_t off = 0;
  p.xb = (bf16_t*)(ws + off); p.ys = (bf16_t*)(ws + off + ((size_t)64 << 20)); p.go = (bf16_t*)(ws + off); p.hb = (bf16_t*)(ws + off + ((size_t)64 << 20)); off += (size_t)128 << 20;
  p.wt0 = (bf16_t*)(ws + off); off += (size_t)N0P * DM * 2;
  p.wto0 = (bf16_t*)(ws + off); off += (size_t)DM * DM * 2;
  p.wt1 = (bf16_t*)(ws + off); off += (size_t)N1W * DM * 2;
  p.wto1 = (bf16_t*)(ws + off); off += (size_t)DM * DM * 2;
  p.ycat = (bf16_t*)(ws + off); off += (size_t)NTOK * DM * 2;
  p.beta = (float*)(ws + off); off += (size_t)2 * NB_ * T_ * 8 * 4;
  p.proj = (bf16_t*)(ws + off);
  p.x1k = (bf16_t*)(ws + off + (size_t)NTOK * N1P * 2);
  p.bar = (unsigned*)(ws + ((size_t)496 << 20));
  p.lrb = (bf16_t*)(ws + ((size_t)498 << 20));
  p.ph_lo = 0; p.ph_hi = 10;
  static int grid_blocks = 0;
  if (!grid_blocks) {
    int dev = 0, cus = 0, per_cu = 0;
    hipGetDevice(&dev);
    hipDeviceGetAttribute(&cus, hipDeviceAttributeMultiprocessorCount, dev);
    hipOccupancyMaxActiveBlocksPerMultiprocessor(&per_cu, mega, NTHR, 0);
    if (per_cu < 1) per_cu = 1;
    if (per_cu > 1) per_cu = 1;
    grid_blocks = cus * per_cu;
  }
#ifdef MULTI_LAUNCH
  for (int ph = 0; ph <= MAXPH; ++ph) {
    p.ph_lo = ph; p.ph_hi = ph;
    hipLaunchKernelGGL(mega, dim3(grid_blocks), dim3(NTHR), 0, stream, p);
  }
  p.ph_lo = 11; p.ph_hi = 11;
  hipLaunchKernelGGL(mega, dim3(grid_blocks), dim3(NTHR), 0, stream, p);
#else
  (void)hipMemsetAsync(p.bar, 0, XCD_BAR_WORDS * sizeof(unsigned), stream);
  void* args[] = {&p};
  hipError_t e = hipLaunchCooperativeKernel((void*)mega, dim3(grid_blocks), dim3(NTHR), args, 0, stream);
  if (e != hipSuccess) fprintf(stderr, "cooperative launch failed: %s (grid %d)\n", hipGetErrorString(e), grid_blocks);
#endif
}
```

```cpp
#include <hip/hip_runtime.h>
#include <hip/hip_cooperative_groups.h>
#include <cstdio>
namespace cg = cooperative_groups;

typedef unsigned short bf16_t;
typedef short bf16x8 __attribute__((ext_vector_type(8)));
typedef float f32x4 __attribute__((ext_vector_type(4)));
typedef float f32x2 __attribute__((ext_vector_type(2)));

#define T_ 2048
#define NB_ 16
#define NTOK 32768
#define DM 1024
#define N0 3776
#define N0P 3840
#define N1 3104
#define N1P 3072
#define N1W 3328
#define ALPHA 1.41421356237f
#define NTHR 512
#define LDS_BYTES 139264

#define MAXPH 1
#define DUMPMODE 1

struct Params {
  const float* x; const float* w_in0; const float* conv_w; const float* conv_b; const float* conv_ln_g; const float* conv_ln_b;
  const float* mu; const float* w0; const float* w_up; const float* a0; const float* a_up; const float* k_k; const float* k_a; const float* r_k;
  const float* gn_g; const float* gn_b; const float* w_out0; const float* ln0_g; const float* ln0_b;
  const float* w_in1; const float* g_up; const float* g_bias; const float* norm_g; const float* w_out1; const float* ln1_g; const float* ln1_b;
  float* out;
  bf16_t* xb; bf16_t* ys; bf16_t* go; bf16_t* hb;
  bf16_t* wt0; bf16_t* wto0; bf16_t* wt1; bf16_t* wto1;
  bf16_t* proj; bf16_t* ycat; float* beta; bf16_t* x1k; unsigned* bar; bf16_t* lrb;
  int ph_lo; int ph_hi;
};

typedef __bf16 bf16x2_t __attribute__((ext_vector_type(2)));
__device__ __forceinline__ unsigned pk_bf16(float lo, float hi) {
  const f32x2 v = (f32x2){lo, hi};
  const bf16x2_t b = __builtin_convertvector(v, bf16x2_t);
  return __builtin_bit_cast(unsigned, b);
}
__device__ __forceinline__ bf16_t f2bf(float v) { return (bf16_t)(pk_bf16(v, 0.f) & 0xffffu); }
__device__ __forceinline__ float bf2f(bf16_t v) { return __uint_as_float(((unsigned)v) << 16); }
__device__ __forceinline__ float sigmoidf_(float x) { return __builtin_amdgcn_rcpf(1.f + __expf(-x)); }
__device__ __forceinline__ float siluf_(float x) { return x * __builtin_amdgcn_rcpf(1.f + __expf(-x)); }
__device__ __forceinline__ float tanhf_(float x) { return 1.f - 2.f * __builtin_amdgcn_rcpf(1.f + __expf(2.f * x)); }
template <int CTRL> __device__ __forceinline__ float dppf0(float x) {
  return __int_as_float(__builtin_amdgcn_update_dpp(0, __float_as_int(x), CTRL, 0xF, 0xF, true));
}
__device__ __forceinline__ float wave_sum(float v) {
  v += dppf0<0xB1>(v); v += dppf0<0x4E>(v); v += dppf0<0x141>(v); v += dppf0<0x140>(v);
  const int vi = __float_as_int(v);
  const float r0 = __int_as_float(__builtin_amdgcn_readlane(vi, 0)), r1 = __int_as_float(__builtin_amdgcn_readlane(vi, 16));
  const float r2 = __int_as_float(__builtin_amdgcn_readlane(vi, 32)), r3 = __int_as_float(__builtin_amdgcn_readlane(vi, 48));
  return (r0 + r1) + (r2 + r3);
}
template <int CTRL> __device__ __forceinline__ float dppf(float x) {
  return __int_as_float(__builtin_amdgcn_update_dpp(0, __float_as_int(x), CTRL, 0xF, 0xF, true));
}

__device__ __forceinline__ void wtrans_tile(const float* __restrict__ W, int N, bf16_t* __restrict__ Wt, int kt, int nt, float* tile) {
  const int tid = threadIdx.x;
  const int k0 = kt * 64, n0 = nt * 64;
  {
    const int r = tid >> 4, c4 = (tid & 15) * 4;
#pragma unroll
    for (int hh = 0; hh < 2; ++hh) {
      const int rr = r + hh * 32;
      float4 v = make_float4(0.f, 0.f, 0.f, 0.f);
      if (n0 + c4 < N) v = *(const float4*)(W + (size_t)(k0 + rr) * N + n0 + c4);
      tile[rr * 65 + c4 + 0] = v.x; tile[rr * 65 + c4 + 1] = v.y; tile[rr * 65 + c4 + 2] = v.z; tile[rr * 65 + c4 + 3] = v.w;
    }
  }
  __syncthreads();
  {
    const int n = tid >> 3, k8 = (tid & 7) * 8;
    float v[8];
#pragma unroll
    for (int i = 0; i < 8; ++i) v[i] = tile[(k8 + i) * 65 + n];
    uint4 o; o.x = pk_bf16(v[0], v[1]); o.y = pk_bf16(v[2], v[3]); o.z = pk_bf16(v[4], v[5]); o.w = pk_bf16(v[6], v[7]);
    *(uint4*)(Wt + (size_t)(n0 + n) * DM + k0 + k8) = o;
  }
  __syncthreads();
}

__device__ __forceinline__ void phase_prep(const Params& p, char* smem) {
  const size_t n8 = (size_t)NTOK * DM / 8;
  for (size_t i = (size_t)blockIdx.x * NTHR + threadIdx.x; i < n8; i += (size_t)gridDim.x * NTHR) {
    const float4* src = (const float4*)(p.x) + i * 2;
    float4 a = src[0], b = src[1];
    uint4 o; o.x = pk_bf16(a.x, a.y); o.y = pk_bf16(a.z, a.w); o.z = pk_bf16(b.x, b.y); o.w = pk_bf16(b.z, b.w);
    ((uint4*)p.xb)[i] = o;
  }
  float* tile = (float*)smem;
  for (int u = blockIdx.x; u < 960; u += gridDim.x) wtrans_tile(p.w_in0, N0, p.wt0, u / 60, u % 60, tile);
}

__device__ __forceinline__ void phase_prep_late(const Params& p, char* smem) {
  float* tile = (float*)smem;
  const int G = (int)gridDim.x, rem = 1920 % G;
  const int first = rem, nidle = G - first;
  if ((int)blockIdx.x < first) return;
  for (int u = 960 + ((int)blockIdx.x - first); u < 2304; u += nidle) {
    if (u < 1216) { const int v = u - 960; wtrans_tile(p.w_out0, DM, p.wto0, v / 16, v % 16, tile); }
    else if (u < 2048) { const int v = u - 1216; wtrans_tile(p.w_in1, N1, p.wt1, v / 52, v % 52, tile); }
    else { const int v = u - 2048; wtrans_tile(p.w_out1, DM, p.wto1, v / 16, v % 16, tile); }
  }
}

namespace pg8 {
#define PG8_LAS __attribute__((address_space(3)))
constexpr int BM = 256, BK = 64, HALF = 128, HTB = HALF * BK * 2, NXCD = 8, WGM = 8;
__device__ __forceinline__ int lds_byte(int r, int c) { const int st = (r >> 4) * 2 + (c >> 5), rr = r & 15, cc = c & 31, ob = rr * 64 + cc * 2; return st * 1024 + (ob ^ (((ob >> 9) & 1) << 5)); }
__device__ __forceinline__ void stage_rc(int b, int& R, int& C) { const int st = b / 1024, sb = b % 1024, swz = sb ^ (((sb >> 9) & 1) << 5); R = (st >> 1) * 16 + swz / 64; C = (st & 1) * 32 + (swz % 64) / 2; }
__device__ __forceinline__ int perm32(int rho) { const int n = rho >> 4, i = rho & 15; return 8 * (i >> 2) + 4 * n + (i & 3); }
struct Unit { int pm, pn; };
struct Gemm { const bf16_t* A; const bf16_t* Bt; int M, N, K; };
struct StaticOrder {
  int nM, nN, nwg, G, c;
  __device__ void init(int M, int N, int G_, int c_) { nM = M / BM; nN = N / BM; nwg = nM * nN; G = G_; c = c_; }
  __device__ bool next(int i, Unit& u) const {
    const long L = (long)i * G + c; if (L >= nwg) return false;
    int wgid = (int)L; { const int q = nwg / NXCD, r = nwg % NXCD, xcd = wgid % NXCD, off = wgid / NXCD; wgid = (xcd < r ? xcd * (q + 1) : r * (q + 1) + (xcd - r) * q) + off; }
    const int nig = WGM * nN, gid = wgid / nig, fm = gid * WGM, gsz = (nM - fm) < WGM ? (nM - fm) : WGM;
    u.pm = fm + ((wgid % nig) % gsz); u.pn = (wgid % nig) / gsz; return true;
  }
};
struct EpiBf16 {
  static constexpr bool PERM = true;
  bf16_t* O; int ldc;
  __device__ __forceinline__ void operator()(const f32x4 (&acc)[2][2][4][2], const Unit& u, int wr, int wc, int fr, int fq) const {
    const int row0 = u.pm * BM + wr * 64 + fr, col0 = u.pn * BM + wc * 32 + 8 * fq;
#pragma unroll
    for (int ai = 0; ai < 2; ++ai)
#pragma unroll
      for (int m = 0; m < 4; ++m) {
        bf16_t* rowp = O + (size_t)(row0 + ai * HALF + m * 16) * ldc + col0;
#pragma unroll
        for (int bj = 0; bj < 2; ++bj) {
          const f32x4 v0 = acc[ai][bj][m][0], v1 = acc[ai][bj][m][1];
          uint4 o; o.x = pk_bf16(v0[0], v0[1]); o.y = pk_bf16(v0[2], v0[3]); o.z = pk_bf16(v1[0], v1[1]); o.w = pk_bf16(v1[2], v1[3]);
          *(uint4*)(rowp + bj * HALF) = o;
        }
      }
  }
};
struct EpiRes {
  static constexpr bool PERM = false;
  const float* X; float* Y;
  __device__ __forceinline__ void operator()(const f32x4 (&acc)[2][2][4][2], const Unit& u, int wr, int wc, int fr, int fq) const {
    const int row0 = u.pm * BM + wr * 64 + fr, col0 = u.pn * BM + wc * 32 + 4 * fq;
#pragma unroll
    for (int ai = 0; ai < 2; ++ai)
#pragma unroll
      for (int m = 0; m < 4; ++m) {
        const size_t ro = (size_t)(row0 + ai * HALF + m * 16) * DM + col0;
#pragma unroll
        for (int bj = 0; bj < 2; ++bj)
#pragma unroll
          for (int n = 0; n < 2; ++n) {
            const f32x4 xr = *(const f32x4*)(X + ro + bj * HALF + n * 16);
            *(f32x4*)(Y + ro + bj * HALF + n * 16) = xr * ALPHA + acc[ai][bj][m][n];
          }
      }
  }
};

template <class Epi>
__device__ __forceinline__ void gemm_phase(PG8_LAS unsigned char* lds, const Gemm g, const StaticOrder& S, const Epi& E) {
  const int tid = threadIdx.x, wid = __builtin_amdgcn_readfirstlane(tid >> 6), lane = tid & 63, wr = wid >> 2, wc = wid & 3, fr = lane & 15, fq = lane >> 4;
  const int K = g.K, nt = K / BK;
  unsigned voffA[2], voffB[2];
#pragma unroll
  for (int i = 0; i < 2; ++i) { int R, C; stage_rc(tid * 16 + i * 8192, R, C); const int Rb = Epi::PERM ? ((R & ~31) + perm32(R & 31)) : R;
    voffA[i] = (unsigned)(R * K + C) * 2u; voffB[i] = (unsigned)(Rb * K + C) * 2u; }
  const size_t kstep = (size_t)(BK * 2);
  const size_t hstep = (size_t)HALF * K * 2;
  const size_t tstep = 2 * hstep;
  const unsigned ldsw = (unsigned)wid * 1024u;
  const int aoff = lds_byte(wr * 64 + fr, fq * 8), boff = lds_byte(wc * 32 + fr, fq * 8);
#define PG8_SA(b, h) (((b) * 2 + (h)) * HTB)
#define PG8_SB(b, h) ((4 + (b) * 2 + (h)) * HTB)
#define PG8_STAGE(bufoff, gbase, voff) do { _Pragma("unroll") for (int _i = 0; _i < 2; ++_i) \
    __builtin_amdgcn_global_load_lds((const unsigned*)((const char*)(gbase) + (voff)[_i]), (PG8_LAS unsigned*)(lds + (bufoff) + ldsw + _i * 8192), 16, 0, 0); } while (0)
#define PG8_LDA(dst, b, h) do { _Pragma("unroll") for (int m = 0; m < 4; ++m) _Pragma("unroll") for (int k = 0; k < 2; ++k) dst[m][k] = *(const PG8_LAS bf16x8*)(lds + PG8_SA(b, h) + aoff + m * 2048 + k * 1024); } while (0)
#define PG8_LDB(dst, b, h) do { _Pragma("unroll") for (int n = 0; n < 2; ++n) _Pragma("unroll") for (int k = 0; k < 2; ++k) dst[n][k] = *(const PG8_LAS bf16x8*)(lds + PG8_SB(b, h) + boff + n * 2048 + k * 1024); } while (0)
#define PG8_MMA(ai, bj, At, Bt) do { __builtin_amdgcn_s_setprio(1); _Pragma("unroll") for (int m = 0; m < 4; ++m) _Pragma("unroll") for (int n = 0; n < 2; ++n) _Pragma("unroll") for (int k = 0; k < 2; ++k) \
    acc[ai][bj][m][n] = __builtin_amdgcn_mfma_f32_16x16x32_bf16(Bt[n][k], At[m][k], acc[ai][bj][m][n], 0, 0, 0); __builtin_amdgcn_s_setprio(0); } while (0)
#define PG8_WAIT_V(n) asm volatile("s_waitcnt vmcnt(" #n ")" ::: "memory")
#define PG8_WAIT_L(n) asm volatile("s_waitcnt lgkmcnt(" #n ")" ::: "memory")
#define PG8_BAR __builtin_amdgcn_s_barrier()
#define PG8_SCHED __builtin_amdgcn_sched_barrier(0)
  Unit cur, nxt; int ui = 0;
  if (!S.next(0, cur)) return;
  f32x4 acc[2][2][4][2];
#pragma unroll
  for (int a = 0; a < 2; ++a)
#pragma unroll
    for (int b = 0; b < 2; ++b)
#pragma unroll
      for (int m = 0; m < 4; ++m)
#pragma unroll
        for (int n = 0; n < 2; ++n) acc[a][b][m][n] = (f32x4){0.f, 0.f, 0.f, 0.f};
  bf16x8 At[4][2], B0[2][2], B1[2][2];
  const char* cA = (const char*)g.A + (size_t)cur.pm * tstep; const char* cB = (const char*)g.Bt + (size_t)cur.pn * tstep;
  PG8_STAGE(PG8_SB(0, 0), cB, voffB); PG8_STAGE(PG8_SA(0, 0), cA, voffA); PG8_STAGE(PG8_SB(0, 1), cB + hstep, voffB); PG8_STAGE(PG8_SA(0, 1), cA + hstep, voffA);
  if (wr == 1) PG8_BAR;
  PG8_WAIT_V(4); PG8_BAR;
  PG8_STAGE(PG8_SB(1, 0), cB + kstep, voffB); PG8_STAGE(PG8_SA(1, 0), cA + kstep, voffA); PG8_STAGE(PG8_SB(1, 1), cB + hstep + kstep, voffB);
  PG8_WAIT_V(6); PG8_BAR;
  for (;;) {
    const bool has_next = S.next(ui + 1, nxt);
    const char* nA = has_next ? (const char*)g.A + (size_t)nxt.pm * tstep : cA; const char* nB = has_next ? (const char*)g.Bt + (size_t)nxt.pn * tstep : cB;
    for (int t = 0; t < nt; t += 2) {
      const bool last = (t == nt - 2);
      const char* a1 = cA + (size_t)(t + 1) * kstep;
      const char* a2 = last ? nA : cA + (size_t)(t + 2) * kstep; const char* b2 = last ? nB : cB + (size_t)(t + 2) * kstep;
      const char* a3 = a2 + kstep; const char* b3 = b2 + kstep;
      PG8_LDB(B0, 0, 0); PG8_SCHED; PG8_LDA(At, 0, 0); PG8_STAGE(PG8_SA(1, 1), a1 + hstep, voffA);
      PG8_WAIT_L(8); PG8_BAR; PG8_WAIT_L(0); PG8_MMA(0, 0, At, B0); PG8_BAR; PG8_SCHED;
      PG8_LDB(B1, 0, 1); PG8_STAGE(PG8_SB(0, 0), b2, voffB);
      PG8_BAR; PG8_WAIT_L(0); PG8_MMA(0, 1, At, B1); PG8_BAR;
      PG8_LDA(At, 0, 1); PG8_STAGE(PG8_SA(0, 0), a2, voffA);
      PG8_BAR; PG8_WAIT_L(0); PG8_MMA(1, 0, At, B0); PG8_BAR; PG8_SCHED;
      PG8_STAGE(PG8_SB(0, 1), b2 + hstep, voffB);
      PG8_WAIT_V(6); PG8_BAR; PG8_MMA(1, 1, At, B1); PG8_BAR;
      PG8_LDB(B0, 1, 0); PG8_SCHED; PG8_LDA(At, 1, 0); PG8_STAGE(PG8_SA(0, 1), a2 + hstep, voffA);
      PG8_WAIT_L(8); PG8_BAR; PG8_WAIT_L(0); PG8_MMA(0, 0, At, B0); PG8_BAR; PG8_SCHED;
      PG8_LDB(B1, 1, 1); PG8_STAGE(PG8_SB(1, 0), b3, voffB);
      PG8_BAR; PG8_WAIT_L(0); PG8_MMA(0, 1, At, B1); PG8_BAR;
      PG8_LDA(At, 1, 1); PG8_STAGE(PG8_SA(1, 0), a3, voffA);
      PG8_BAR; PG8_WAIT_L(0); PG8_MMA(1, 0, At, B0); PG8_BAR; PG8_SCHED;
      PG8_STAGE(PG8_SB(1, 1), b3 + hstep, voffB);
      PG8_WAIT_V(6); PG8_BAR; PG8_MMA(1, 1, At, B1); PG8_BAR;
    }
    E(acc, cur, wr, wc, fr, fq);
    if (!has_next) break;
#pragma unroll
    for (int a = 0; a < 2; ++a)
#pragma unroll
      for (int b = 0; b < 2; ++b)
#pragma unroll
        for (int m = 0; m < 4; ++m)
#pragma unroll
          for (int n = 0; n < 2; ++n) acc[a][b][m][n] = (f32x4){0.f, 0.f, 0.f, 0.f};
    cur = nxt; cA = nA; cB = nB; ++ui;
  }
  PG8_WAIT_V(0);
  if (wr == 0) PG8_BAR;
  PG8_BAR;
#undef PG8_SA
#undef PG8_SB
#undef PG8_STAGE
#undef PG8_LDA
#undef PG8_LDB
#undef PG8_MMA
#undef PG8_WAIT_V
#undef PG8_WAIT_L
#undef PG8_BAR
#undef PG8_SCHED
}
}

template <class Epi>
__device__ __forceinline__ void gemm_run(const bf16_t* A, const bf16_t* Bt, int N, const Epi& E, char* smem) {
  pg8::Gemm g; g.A = A; g.Bt = Bt; g.M = NTOK; g.N = N; g.K = DM;
  pg8::StaticOrder S; S.init(NTOK, N, (int)gridDim.x, (int)blockIdx.x);
  pg8::gemm_phase<Epi>((PG8_LAS unsigned char*)smem, g, S, E);
  __syncthreads();
}

__device__ __forceinline__ void phase_conv(const Params& p, char* smem) {
  float* u = (float*)smem;
  const int tid = threadIdx.x, lane = tid & 63, wid = tid >> 6;
  const int c = tid;
  float w[31];
#pragma unroll
  for (int j = 0; j < 31; ++j) w[j] = p.conv_w[j * 512 + c];
  const float bias = p.conv_b[c];
  const int c8 = lane * 8;
  for (int tile = blockIdx.x; tile < 1024; tile += gridDim.x) {
    const int b = tile >> 6, t0 = (tile & 63) * 32;
#pragma unroll
    for (int it = 0; it < 8; ++it) {
      const int tt = wid + 8 * it;
      if (tt < 62) {
        const int t = t0 - 15 + tt;
        f32x4 u0 = (f32x4){0.f, 0.f, 0.f, 0.f}, u1 = (f32x4){0.f, 0.f, 0.f, 0.f};
        if (t >= 0 && t < T_) {
          const bf16_t* row = p.proj + (size_t)(b * T_ + t) * N0P;
          const uint4 v4 = *(const uint4*)(row + c8), g4 = *(const uint4*)(row + 512 + c8);
          const unsigned vw[4] = {v4.x, v4.y, v4.z, v4.w}, gw[4] = {g4.x, g4.y, g4.z, g4.w};
          float uu[8];
#pragma unroll
          for (int j = 0; j < 4; ++j) {
            uu[2 * j] = __uint_as_float(vw[j] << 16) * sigmoidf_(__uint_as_float(gw[j] << 16));
            uu[2 * j + 1] = __uint_as_float(vw[j] & 0xffff0000u) * sigmoidf_(__uint_as_float(gw[j] & 0xffff0000u));
          }
          u0 = (f32x4){uu[0], uu[1], uu[2], uu[3]}; u1 = (f32x4){uu[4], uu[5], uu[6], uu[7]};
        }
        *(f32x4*)(u + tt * 512 + c8) = u0; *(f32x4*)(u + tt * 512 + c8 + 4) = u1;
      }
    }
    __syncthreads();
    {
      float uin[47];
#pragma unroll
      for (int hh = 0; hh < 2; ++hh) {
#pragma unroll
        for (int r = 0; r < 46; ++r) uin[r] = u[(hh * 16 + r) * 512 + c];
        float accs[16];
#pragma unroll
        for (int ti = 0; ti < 16; ++ti) {
          float acc = bias;
#pragma unroll
          for (int j = 0; j < 31; ++j) acc += w[j] * uin[ti + j];
          accs[ti] = acc;
        }
        __syncthreads();
#pragma unroll
        for (int ti = 0; ti < 16; ++ti) u[(hh * 16 + ti) * 512 + c] = accs[ti];
      }
    }
    __syncthreads();
#pragma unroll 2
    for (int ti = wid; ti < 32; ti += 8) {
      const size_t tok = (size_t)b * T_ + t0 + ti;
      const uint4 g4 = *(const uint4*)(p.proj + tok * N0P + 1024 + c8);
      const f32x4 a0 = *(const f32x4*)(u + ti * 512 + c8), a1 = *(const f32x4*)(u + ti * 512 + c8 + 4);
      float v[8] = {a0[0], a0[1], a0[2], a0[3], a1[0], a1[1], a1[2], a1[3]};
      float s = 0.f;
#pragma unroll
      for (int i = 0; i < 8; ++i) s += v[i];
      const float mean = wave_sum(s) * (1.f / 512.f);
      float q = 0.f;
#pragma unroll
      for (int i = 0; i < 8; ++i) { v[i] -= mean; q += v[i] * v[i]; }
      const float rstd = rsqrtf(wave_sum(q) * (1.f / 512.f) + 1e-5f);
      const f32x4 lg0 = *(const f32x4*)(p.conv_ln_g + c8), lg1 = *(const f32x4*)(p.conv_ln_g + c8 + 4);
      const f32x4 lb0 = *(const f32x4*)(p.conv_ln_b + c8), lb1 = *(const f32x4*)(p.conv_ln_b + c8 + 4);
      const unsigned gw[4] = {g4.x, g4.y, g4.z, g4.w};
      unsigned ow[4];
#pragma unroll
      for (int j = 0; j < 4; ++j) {
        const float lga = (j < 2) ? lg0[2 * j] : lg1[2 * j - 4], lgb = (j < 2) ? lg0[2 * j + 1] : lg1[2 * j - 3];
        const float lba = (j < 2) ? lb0[2 * j] : lb1[2 * j - 4], lbb = (j < 2) ? lb0[2 * j + 1] : lb1[2 * j - 3];
        float ya = siluf_(v[2 * j] * rstd * lga + lba), yb = siluf_(v[2 * j + 1] * rstd * lgb + lbb);
        ya *= siluf_(__uint_as_float(gw[j] << 16)); yb *= siluf_(__uint_as_float(gw[j] & 0xffff0000u));
        ow[j] = pk_bf16(ya, yb);
      }
      *(uint4*)(p.ycat + tok * DM + c8) = make_uint4(ow[0], ow[1], ow[2], ow[3]);
    }
    __syncthreads();
  }
}

__device__ __forceinline__ void phase_scan(const Params& p, char* smem) {
  bf16_t* WupT = (bf16_t*)smem;
  bf16_t* AupT = (bf16_t*)(smem + 9216);
  float* MU = (float*)(smem + 14336);
  bf16_t* SB = (bf16_t*)(smem + 15488);
  bf16_t* TW = (bf16_t*)(smem + 24704);
  bf16_t* AL = (bf16_t*)(smem + 29312);
  float* WP = (float*)(smem + 31872);
  float* AP = (float*)(smem + 40064);
  float* GT = (float*)(smem + 131200);
  float* GC = (float*)(smem + 133248);
  float* KKv = (float*)(smem + 48256); float* Bv = KKv + 2048; float* KMv = Bv + 2048; float* LWv = KMv + 2048;
  float* Rv = LWv + 2048; float* Vv = Rv + 2048;
  bf16_t* MAK = (bf16_t*)(smem + 48256);
  bf16_t* MRB = (bf16_t*)(smem + 50816);
  bf16_t* MRK = (bf16_t*)(smem + 53376);
  float* MAB = (float*)(smem + 55936);
  float* Wb = (float*)(smem + 60544);
  bf16_t* UT = (bf16_t*)(smem + 69248);
  bf16_t* RAW = (bf16_t*)(smem + 97408);
  bf16_t* AH = (bf16_t*)(smem + 97408);
  bf16_t* BH = (bf16_t*)(smem + 102016);
  bf16_t* KH = (bf16_t*)(smem + 106624);
  bf16_t* RH = (bf16_t*)(smem + 111232);
  bf16_t* BTT = (bf16_t*)(smem + 115840);
  bf16_t* KTT = (bf16_t*)(smem + 120960);
  bf16_t* VT = (bf16_t*)(smem + 126080);
  const int tid = threadIdx.x, lane = tid & 63, wid = tid >> 6;
  const int fr = lane & 15, fq = lane >> 4;
  for (int seq = blockIdx.x; seq < 256; seq += gridDim.x) {
    const int d = seq >> 7, b = (seq >> 3) & 15, h = seq & 7;
    __syncthreads();
    if (tid < 288) MU[tid] = (tid < 192) ? p.mu[(tid >> 6) * 512 + h * 64 + (tid & 63)] : p.mu[1536 + d * 96 + (tid - 192)];
#pragma unroll
    for (int i = 0; i < 8; ++i) { const int e = tid + 512 * i; const int j = e >> 6, c = e & 63; WupT[c * 72 + j] = f2bf(p.w_up[((size_t)d * 64 + j) * 512 + h * 64 + c]); }
#pragma unroll
    for (int i = 0; i < 4; ++i) { const int e = tid + 512 * i; const int j = e >> 6, c = e & 63; AupT[c * 40 + j] = f2bf(p.a_up[((size_t)d * 32 + j) * 512 + h * 64 + c]); }
    const int ptok = tid >> 4, pc4 = (tid & 15) * 4;
    float w0v[4], a0v[4], kkc[4], kac[4], rkc[4];
#pragma unroll
    for (int i = 0; i < 4; ++i) {
      const int ch = h * 64 + pc4 + i;
      w0v[i] = p.w0[d * 512 + ch]; a0v[i] = p.a0[d * 512 + ch]; kkc[i] = p.k_k[ch]; kac[i] = p.k_a[ch]; rkc[i] = p.r_k[ch];
    }
    f32x4 accS[2];
    accS[0] = (f32x4){0.f, 0.f, 0.f, 0.f}; accS[1] = (f32x4){0.f, 0.f, 0.f, 0.f};
    for (int i = tid; i < 64 * 72 / 2; i += NTHR) ((unsigned*)SB)[i] = 0u;
    const bf16_t* pbase = p.proj + (size_t)b * T_ * N0P;
    uint4 pc0, pp0, pn0, pc1, pp1, pn1, pc2, pp2, pn2;
#define SCAN_LD(PC, PP, PN, TOK, CK, CI) do { \
      const int s_ = (CI) * 32 + (TOK); const int t_ = d ? (T_ - 1 - s_) : s_; \
      const int col_ = ((CK) < 24) ? (1536 + ((CK) >> 3) * 512 + h * 64 + ((CK) & 7) * 8) : (3072 + d * 96 + ((CK) - 24) * 8); \
      const bf16_t* g_ = pbase + (size_t)t_ * N0P + col_; \
      PC = *(const uint4*)g_; PP = make_uint4(0u, 0u, 0u, 0u); PN = make_uint4(0u, 0u, 0u, 0u); \
      if (t_ > 0) PP = *(const uint4*)(g_ - N0P); \
      if (t_ < T_ - 1) PN = *(const uint4*)(g_ + N0P); } while (0)
#define SCAN_ITEMS(TID) \
      const int tokA = (TID) / 24, ckA = (TID) - tokA * 24; \
      const int tokB = ((TID) + 512) / 24, ckB = ((TID) + 512) - tokB * 24; \
      const int tokC = (wid < 4) ? ((TID) >> 3) : (((TID) - 256) >> 2), ckC = (wid < 4) ? (24 + ((TID) & 7)) : (32 + (((TID) - 256) & 3));
#define SCAN_LOAD_ALL(CI) do { \
      SCAN_LD(pc0, pp0, pn0, tokA, ckA, CI); \
      if (wid < 4) SCAN_LD(pc1, pp1, pn1, tokB, ckB, CI); \
      if (wid < 6) SCAN_LD(pc2, pp2, pn2, tokC, ckC, CI); } while (0)
    {
      SCAN_ITEMS((int)threadIdx.x)
      pc1 = pp1 = pn1 = pc2 = pp2 = pn2 = make_uint4(0u, 0u, 0u, 0u);
      SCAN_LOAD_ALL(0);
    }
    for (int ci = 0; ci < 64; ++ci) {
      int lz = 0; asm volatile("" : "+v"(lz));
      const int tid = (int)threadIdx.x + lz, lane = tid & 63, fr = lane & 15, fq = lane >> 4, ptok = tid >> 4, pc4 = (tid & 15) * 4;
      SCAN_ITEMS(tid)
#define SHIFT8(ZC, ZP, ZN, CK, VAL) do { \
        const f32x4 m0 = *(const f32x4*)(MU + (CK) * 8), m1 = *(const f32x4*)(MU + (CK) * 8 + 4); \
        const unsigned zcw[4] = {ZC.x, ZC.y, ZC.z, ZC.w}, zpw[4] = {ZP.x, ZP.y, ZP.z, ZP.w}, znw[4] = {ZN.x, ZN.y, ZN.z, ZN.w}; \
        _Pragma("unroll") for (int j = 0; j < 4; ++j) { \
          const float c0 = __uint_as_float(zcw[j] << 16), c1 = __uint_as_float(zcw[j] & 0xffff0000u); \
          const float p0 = __uint_as_float(zpw[j] << 16), p1 = __uint_as_float(zpw[j] & 0xffff0000u); \
          const float n0 = __uint_as_float(znw[j] << 16), n1 = __uint_as_float(znw[j] & 0xffff0000u); \
          const float mm0 = (j < 2) ? m0[2 * j] : m1[2 * j - 4], mm1 = (j < 2) ? m0[2 * j + 1] : m1[2 * j - 3]; \
          VAL[2 * j] = c0 + mm0 * (0.5f * (p0 + n0) - c0); \
          VAL[2 * j + 1] = c1 + mm1 * (0.5f * (p1 + n1) - c1); } } while (0)
      {
        float val[8];
        SHIFT8(pc0, pp0, pn0, ckA, val);
        float* dst = (ckA < 8) ? Rv : ((ckA < 16) ? KMv : Vv);
        *(f32x4*)(dst + tokA * 64 + (ckA & 7) * 8) = (f32x4){val[0], val[1], val[2], val[3]};
        *(f32x4*)(dst + tokA * 64 + (ckA & 7) * 8 + 4) = (f32x4){val[4], val[5], val[6], val[7]};
      }
      if (wid < 4) {
        float val[8];
        SHIFT8(pc1, pp1, pn1, ckB, val);
        float* dst = (ckB < 8) ? Rv : ((ckB < 16) ? KMv : Vv);
        *(f32x4*)(dst + tokB * 64 + (ckB & 7) * 8) = (f32x4){val[0], val[1], val[2], val[3]};
        *(f32x4*)(dst + tokB * 64 + (ckB & 7) * 8 + 4) = (f32x4){val[4], val[5], val[6], val[7]};
      }
      if (wid < 4) {
        float val[8];
        SHIFT8(pc2, pp2, pn2, ckC, val);
        uint4 o; o.x = pk_bf16(tanhf_(val[0]), tanhf_(val[1])); o.y = pk_bf16(tanhf_(val[2]), tanhf_(val[3]));
        o.z = pk_bf16(tanhf_(val[4]), tanhf_(val[5])); o.w = pk_bf16(tanhf_(val[6]), tanhf_(val[7]));
        *(uint4*)(TW + tokC * 72 + (ckC - 24) * 8) = o;
      } else if (wid < 6) {
        float val[8];
        SHIFT8(pc2, pp2, pn2, ckC, val);
        uint4 o; o.x = pk_bf16(val[0], val[1]); o.y = pk_bf16(val[2], val[3]); o.z = pk_bf16(val[4], val[5]); o.w = pk_bf16(val[6], val[7]);
        *(uint4*)(AL + tokC * 40 + (ckC - 32) * 8) = o;
      }
#undef SHIFT8
      if (ci + 1 < 64) SCAN_LOAD_ALL(ci + 1);
      __syncthreads();
      {
        const int mt = wid >> 2, nt = wid & 3;
        f32x4 accw = (f32x4){0.f, 0.f, 0.f, 0.f}, acca = (f32x4){0.f, 0.f, 0.f, 0.f};
#pragma unroll
        for (int ks = 0; ks < 2; ++ks) {
          const bf16x8 a_op = *(const bf16x8*)(TW + (mt * 16 + fr) * 72 + ks * 32 + fq * 8);
          const bf16x8 b_op = *(const bf16x8*)(WupT + (nt * 16 + fr) * 72 + ks * 32 + fq * 8);
          accw = __builtin_amdgcn_mfma_f32_16x16x32_bf16(a_op, b_op, accw, 0, 0, 0);
        }
        {
          const bf16x8 a_op = *(const bf16x8*)(AL + (mt * 16 + fr) * 40 + fq * 8);
          const bf16x8 b_op = *(const bf16x8*)(AupT + (nt * 16 + fr) * 40 + fq * 8);
          acca = __builtin_amdgcn_mfma_f32_16x16x32_bf16(a_op, b_op, acca, 0, 0, 0);
        }
#pragma unroll
        for (int r = 0; r < 4; ++r) {
          WP[(mt * 16 + fq * 4 + r) * 64 + nt * 16 + fr] = accw[r];
          AP[(mt * 16 + fq * 4 + r) * 64 + nt * 16 + fr] = acca[r];
        }
      }
      __syncthreads();
      {
        const f32x4 wp = *(const f32x4*)(WP + ptok * 64 + pc4);
        const f32x4 ap = *(const f32x4*)(AP + ptok * 64 + pc4);
        const f32x4 kr = *(const f32x4*)(KMv + ptok * 64 + pc4);
        const f32x4 rv = *(const f32x4*)(Rv + ptok * 64 + pc4);
        f32x2 kkv[2], av[2], lwv[2], kmv[2];
        f32x2 ssq2 = (f32x2){0.f, 0.f}, bet2 = (f32x2){0.f, 0.f};
#pragma unroll
        for (int hp = 0; hp < 2; ++hp) {
          const f32x2 wx = (f32x2){w0v[2 * hp], w0v[2 * hp + 1]} + (f32x2){wp[2 * hp], wp[2 * hp + 1]};
          const f32x2 ax = (f32x2){a0v[2 * hp], a0v[2 * hp + 1]} + (f32x2){ap[2 * hp], ap[2 * hp + 1]};
          f32x2 sg, sa_;
          sg[0] = sigmoidf_(wx[0]); sg[1] = sigmoidf_(wx[1]);
          sa_[0] = sigmoidf_(ax[0]); sa_[1] = sigmoidf_(ax[1]);
          lwv[hp] = sg * (-0.60653065971f);
          av[hp] = sa_;
          const f32x2 k2 = (f32x2){kr[2 * hp], kr[2 * hp + 1]};
          kkv[hp] = k2 * (f32x2){kkc[2 * hp], kkc[2 * hp + 1]};
          ssq2 += kkv[hp] * kkv[hp];
          kmv[hp] = k2 * ((sa_ - 1.f) * (f32x2){kac[2 * hp], kac[2 * hp + 1]} + 1.f);
          bet2 += (f32x2){rv[2 * hp], rv[2 * hp + 1]} * kmv[hp] * (f32x2){rkc[2 * hp], rkc[2 * hp + 1]};
        }
        float ssq = ssq2[0] + ssq2[1], bet = bet2[0] + bet2[1];
        for (int m = 0; m < 1; ++m) {
          ssq += dppf<0xB1>(ssq); bet += dppf<0xB1>(bet);
          ssq += dppf<0x4E>(ssq); bet += dppf<0x4E>(bet);
          ssq += dppf<0x141>(ssq); bet += dppf<0x141>(bet);
          ssq += dppf<0x140>(ssq); bet += dppf<0x140>(bet);
        }
        const float rn = rsqrtf(ssq + 1e-12f);
        const f32x2 kk0 = kkv[0] * rn, kk1 = kkv[1] * rn;
        const f32x2 b0 = kk0 * av[0], b1 = kk1 * av[1];
        *(f32x4*)(KKv + ptok * 64 + pc4) = (f32x4){kk0[0], kk0[1], kk1[0], kk1[1]};
        *(f32x4*)(Bv + ptok * 64 + pc4) = (f32x4){b0[0], b0[1], b1[0], b1[1]};
        *(f32x4*)(KMv + ptok * 64 + pc4) = (f32x4){kmv[0][0], kmv[0][1], kmv[1][0], kmv[1][1]};
        *(f32x4*)(LWv + ptok * 64 + pc4) = (f32x4){lwv[0][0], lwv[0][1], lwv[1][0], lwv[1][1]};
        if ((tid & 15) == 0) {
          const int s = ci * 32 + ptok; const int t = d ? (T_ - 1 - s) : s;
          p.beta[(((size_t)d * NB_ + b) * T_ + t) * 8 + h] = bet;
        }
      }
      asm volatile("s_waitcnt lgkmcnt(0)" ::: "memory");
      __builtin_amdgcn_wave_barrier();
      {
        const int c = lane, tg = wid;
        float lw[4], cs[4];
#pragma unroll
        for (int j = 0; j < 4; ++j) lw[j] = LWv[(4 * tg + j) * 64 + c];
        cs[0] = lw[0]; cs[1] = cs[0] + lw[1]; cs[2] = cs[1] + lw[2]; cs[3] = cs[2] + lw[3];
        GT[tg * 64 + c] = cs[3];
        __syncthreads();
        float offs = 0.f, tot = 0.f;
#pragma unroll
        for (int g2 = 0; g2 < 8; ++g2) { const float gv = GT[g2 * 64 + c]; tot += gv; if (g2 < tg) offs += gv; }
        float bt4[4], kt4[4], vt4[4];
        const float etot = __expf(tot);
        float epv = __expf(offs);
#pragma unroll
        for (int j = 0; j < 4; ++j) {
          const int t = 4 * tg + j;
          const float lg = offs + cs[j];
          const float kap = KKv[t * 64 + c], bb = Bv[t * 64 + c], km = KMv[t * 64 + c], rr = Rv[t * 64 + c];
          vt4[j] = Vv[t * 64 + c];
          const float ep = __expf(lg), em = __builtin_amdgcn_rcpf(ep), ec = etot * em;
          AH[t * 72 + c] = f2bf(-kap * epv);
          BH[t * 72 + c] = f2bf(bb * em);
          KH[t * 72 + c] = f2bf(km * em);
          RH[t * 72 + c] = f2bf(rr * ep);
          bt4[j] = bb * ec; kt4[j] = km * ec;
          epv = ep;
        }
        *(uint2*)(BTT + c * 40 + 4 * tg) = make_uint2(pk_bf16(bt4[0], bt4[1]), pk_bf16(bt4[2], bt4[3]));
        *(uint2*)(KTT + c * 40 + 4 * tg) = make_uint2(pk_bf16(kt4[0], kt4[1]), pk_bf16(kt4[2], kt4[3]));
        *(uint2*)(VT + c * 40 + 4 * tg) = make_uint2(pk_bf16(vt4[0], vt4[1]), pk_bf16(vt4[2], vt4[3]));
        if (tg == 0) GC[c] = etot;
      }
      __syncthreads();
      {
        const int mtx = wid >> 1, it = wid & 1;
        const bf16_t* Pi = (mtx & 1) ? KH : BH;
        const bf16_t* Qt = (mtx < 2) ? AH : RH;
        const bf16x8 pa0 = *(const bf16x8*)(Pi + (it * 16 + fr) * 72 + fq * 8);
        const bf16x8 pa1 = *(const bf16x8*)(Pi + (it * 16 + fr) * 72 + 32 + fq * 8);
#pragma unroll
        for (int tt = 0; tt < 2; ++tt) {
          f32x4 acc = (f32x4){0.f, 0.f, 0.f, 0.f};
          const bf16x8 qb0 = *(const bf16x8*)(Qt + (tt * 16 + fr) * 72 + fq * 8);
          const bf16x8 qb1 = *(const bf16x8*)(Qt + (tt * 16 + fr) * 72 + 32 + fq * 8);
          acc = __builtin_amdgcn_mfma_f32_16x16x32_bf16(pa0, qb0, acc, 0, 0, 0);
          acc = __builtin_amdgcn_mfma_f32_16x16x32_bf16(pa1, qb1, acc, 0, 0, 0);
          const int t = tt * 16 + fr, i0 = it * 16 + fq * 4;
          const int lim = (mtx < 2) ? (t - 1) : t;
          f32x4 mk;
#pragma unroll
          for (int r = 0; r < 4; ++r) mk[r] = (i0 + r <= lim) ? acc[r] : 0.f;
          if (mtx == 0) {
#pragma unroll
            for (int r = 0; r < 4; ++r) { const int i = i0 + r; MAB[t * 32 + (i & 3) * 8 + (i >> 2)] = mk[r]; }
          }
          else {
            bf16_t* Mo = (mtx == 1) ? MAK : ((mtx == 2) ? MRB : MRK);
            *(uint2*)(Mo + t * 40 + i0) = make_uint2(pk_bf16(mk[0], mk[1]), pk_bf16(mk[2], mk[3]));
          }
        }
      }
      const int vt_ = wid >> 1, tt_ = wid & 1;
      f32x4 accY = (f32x4){0.f, 0.f, 0.f, 0.f}, accW = (f32x4){0.f, 0.f, 0.f, 0.f};
      {
        const bf16x8 s0 = *(const bf16x8*)(SB + (vt_ * 16 + fr) * 72 + fq * 8);
        const bf16x8 s1 = *(const bf16x8*)(SB + (vt_ * 16 + fr) * 72 + 32 + fq * 8);
        const bf16x8 a0 = *(const bf16x8*)(AH + (tt_ * 16 + fr) * 72 + fq * 8);
        const bf16x8 a1 = *(const bf16x8*)(AH + (tt_ * 16 + fr) * 72 + 32 + fq * 8);
        const bf16x8 r0 = *(const bf16x8*)(RH + (tt_ * 16 + fr) * 72 + fq * 8);
        const bf16x8 r1 = *(const bf16x8*)(RH + (tt_ * 16 + fr) * 72 + 32 + fq * 8);
        accW = __builtin_amdgcn_mfma_f32_16x16x32_bf16(s0, a0, accW, 0, 0, 0);
        accW = __builtin_amdgcn_mfma_f32_16x16x32_bf16(s1, a1, accW, 0, 0, 0);
        accY = __builtin_amdgcn_mfma_f32_16x16x32_bf16(s0, r0, accY, 0, 0, 0);
        accY = __builtin_amdgcn_mfma_f32_16x16x32_bf16(s1, r1, accY, 0, 0, 0);
      }
      __syncthreads();
      {
        const bf16x8 vv = *(const bf16x8*)(VT + (vt_ * 16 + fr) * 40 + fq * 8);
        const bf16x8 mak = *(const bf16x8*)(MAK + (tt_ * 16 + fr) * 40 + fq * 8);
        const bf16x8 mrk = *(const bf16x8*)(MRK + (tt_ * 16 + fr) * 40 + fq * 8);
        accW = __builtin_amdgcn_mfma_f32_16x16x32_bf16(vv, mak, accW, 0, 0, 0);
        accY = __builtin_amdgcn_mfma_f32_16x16x32_bf16(vv, mrk, accY, 0, 0, 0);
        *(f32x4*)(Wb + (tt_ * 16 + fr) * 68 + vt_ * 16 + fq * 4) = accW;
      }
      __syncthreads();
      if (wid < 4) {
        const int q = lane & 3, v = wid * 16 + (lane >> 2);
        f32x2 u01 = (f32x2){0.f, 0.f}, u23 = (f32x2){0.f, 0.f}, u45 = (f32x2){0.f, 0.f}, u67 = (f32x2){0.f, 0.f};
        f32x4 Am0[4], Am1[4], Bm0[4], Bm1[4]; float Aw[4], Bw[4];
#define P6_LOAD(X, T0) do { _Pragma("unroll") for (int s_ = 0; s_ < 4; ++s_) { const int t_ = (T0) + s_; \
          X##m0[s_] = *(const f32x4*)(MAB + t_ * 32 + q * 8); X##m1[s_] = *(const f32x4*)(MAB + t_ * 32 + q * 8 + 4); X##w[s_] = Wb[t_ * 68 + v]; } } while (0)
#define P6_STEPS(X, T0) do { _Pragma("unroll") for (int s_ = 0; s_ < 4; ++s_) { const int t_ = (T0) + s_; \
          f32x2 pa_ = u01 * (f32x2){X##m0[s_][0], X##m0[s_][1]} + u45 * (f32x2){X##m1[s_][0], X##m1[s_][1]}; \
          f32x2 pb_ = u23 * (f32x2){X##m0[s_][2], X##m0[s_][3]} + u67 * (f32x2){X##m1[s_][2], X##m1[s_][3]}; \
          pa_ += pb_; \
          float part = pa_[0] + pa_[1]; \
          part += dppf<0xB1>(part); part += dppf<0x4E>(part); \
          const float ut = X##w[s_] + part; \
          const bool mine = (q == (t_ & 3)); const int j_ = t_ >> 2; \
          if (j_ == 0) u01[0] = mine ? ut : u01[0]; else if (j_ == 1) u01[1] = mine ? ut : u01[1]; \
          else if (j_ == 2) u23[0] = mine ? ut : u23[0]; else if (j_ == 3) u23[1] = mine ? ut : u23[1]; \
          else if (j_ == 4) u45[0] = mine ? ut : u45[0]; else if (j_ == 5) u45[1] = mine ? ut : u45[1]; \
          else if (j_ == 6) u67[0] = mine ? ut : u67[0]; else u67[1] = mine ? ut : u67[1]; } } while (0)
        P6_LOAD(A, 0);
#pragma unroll
        for (int blk = 0; blk < 8; blk += 2) {
          P6_LOAD(B, (blk + 1) * 4);
          P6_STEPS(A, blk * 4);
          if (blk + 2 < 8) P6_LOAD(A, (blk + 2) * 4);
          P6_STEPS(B, (blk + 1) * 4);
        }
#undef P6_LOAD
#undef P6_STEPS
        bf16_t* up = UT + v * 40 + q;
        up[0] = f2bf(u01[0]); up[4] = f2bf(u01[1]); up[8] = f2bf(u23[0]); up[12] = f2bf(u23[1]);
        up[16] = f2bf(u45[0]); up[20] = f2bf(u45[1]); up[24] = f2bf(u67[0]); up[28] = f2bf(u67[1]);
      }
      __syncthreads();
      {
        const bf16x8 uu = *(const bf16x8*)(UT + (vt_ * 16 + fr) * 40 + fq * 8);
        const bf16x8 mrb = *(const bf16x8*)(MRB + (tt_ * 16 + fr) * 40 + fq * 8);
        accY = __builtin_amdgcn_mfma_f32_16x16x32_bf16(uu, mrb, accY, 0, 0, 0);
        const int s = ci * 32 + tt_ * 16 + fr; const int t = d ? (T_ - 1 - s) : s;
        *(uint2*)(p.ys + ((size_t)d * NTOK + (size_t)b * T_ + t) * 512 + h * 64 + vt_ * 16 + fq * 4) = make_uint2(pk_bf16(accY[0], accY[1]), pk_bf16(accY[2], accY[3]));
        const int kt_ = wid >> 1;
        const f32x4 gc = *(const f32x4*)(GC + kt_ * 16 + fq * 4);
        const bf16x8 bt = *(const bf16x8*)(BTT + (kt_ * 16 + fr) * 40 + fq * 8);
        const bf16x8 ktv = *(const bf16x8*)(KTT + (kt_ * 16 + fr) * 40 + fq * 8);
#pragma unroll
        for (int j = 0; j < 2; ++j) {
          const int v2 = (wid & 1) * 2 + j;
          const bf16x8 u2 = *(const bf16x8*)(UT + (v2 * 16 + fr) * 40 + fq * 8);
          const bf16x8 vv2 = *(const bf16x8*)(VT + (v2 * 16 + fr) * 40 + fq * 8);
          accS[j] = accS[j] * gc;
          accS[j] = __builtin_amdgcn_mfma_f32_16x16x32_bf16(bt, u2, accS[j], 0, 0, 0);
          accS[j] = __builtin_amdgcn_mfma_f32_16x16x32_bf16(ktv, vv2, accS[j], 0, 0, 0);
          *(uint2*)(SB + (v2 * 16 + fr) * 72 + kt_ * 16 + fq * 4) = make_uint2(pk_bf16(accS[j][0], accS[j][1]), pk_bf16(accS[j][2], accS[j][3]));
        }
      }
      __syncthreads();
    }
  }
#undef SCAN_LD
#undef SCAN_ITEMS
#undef SCAN_LOAD_ALL
}

__device__ __forceinline__ void phase_rwkv_fin(const Params& p) {
  const int lane = threadIdx.x & 63, wid = threadIdx.x >> 6;
  const int ch0 = lane * 8, h = lane >> 3;
  float gng[8], gnb[8], muv[8];
#pragma unroll
  for (int j = 0; j < 8; ++j) { gng[j] = p.gn_g[ch0 + j]; gnb[j] = p.gn_b[ch0 + j]; muv[j] = p.mu[1024 + ch0 + j]; }
  const int stride = gridDim.x * 8;
  for (int tok0 = blockIdx.x * 8 + wid; tok0 < NTOK; tok0 += 2 * stride) {
    f32x4 ya0[2], ya1[2], yb0[2], yb1[2]; uint4 zc4[2], zp4[2], zn4[2], g4[2]; float bet[2];
#pragma unroll
    for (int r = 0; r < 2; ++r) {
      const int tok = tok0 + r * stride;
      if (tok < NTOK) {
        const int b = tok >> 11, t = tok & 2047;
        {
          const uint4 qa = *(const uint4*)(p.ys + (size_t)tok * 512 + ch0), qb = *(const uint4*)(p.ys + ((size_t)NTOK + tok) * 512 + ch0);
          ya0[r] = (f32x4){__uint_as_float(qa.x << 16), __uint_as_float(qa.x & 0xffff0000u), __uint_as_float(qa.y << 16), __uint_as_float(qa.y & 0xffff0000u)};
          ya1[r] = (f32x4){__uint_as_float(qa.z << 16), __uint_as_float(qa.z & 0xffff0000u), __uint_as_float(qa.w << 16), __uint_as_float(qa.w & 0xffff0000u)};
          yb0[r] = (f32x4){__uint_as_float(qb.x << 16), __uint_as_float(qb.x & 0xffff0000u), __uint_as_float(qb.y << 16), __uint_as_float(qb.y & 0xffff0000u)};
          yb1[r] = (f32x4){__uint_as_float(qb.z << 16), __uint_as_float(qb.z & 0xffff0000u), __uint_as_float(qb.w << 16), __uint_as_float(qb.w & 0xffff0000u)};
        }
        const bf16_t* zp_ = p.proj + (size_t)tok * N0P + 2560 + ch0;
        zc4[r] = *(const uint4*)zp_;
        zp4[r] = make_uint4(0u, 0u, 0u, 0u); zn4[r] = make_uint4(0u, 0u, 0u, 0u);
        if (t > 0) zp4[r] = *(const uint4*)(zp_ - N0P);
        if (t < T_ - 1) zn4[r] = *(const uint4*)(zp_ + N0P);
        g4[r] = *(const uint4*)(p.proj + (size_t)tok * N0P + 3264 + ch0);
        bet[r] = 0.5f * (p.beta[((size_t)b * T_ + t) * 8 + h] + p.beta[(((size_t)NB_ + b) * T_ + t) * 8 + h]);
      }
    }
#pragma unroll
    for (int r = 0; r < 2; ++r) {
      const int tok = tok0 + r * stride;
      if (tok < NTOK) {
        float y[8];
#pragma unroll
        for (int j = 0; j < 4; ++j) { y[j] = ya0[r][j] + yb0[r][j]; y[4 + j] = ya1[r][j] + yb1[r][j]; }
        float sm = 0.f;
#pragma unroll
        for (int j = 0; j < 8; ++j) sm += y[j];
        sm += dppf0<0xB1>(sm); sm += dppf0<0x4E>(sm); sm += dppf0<0x141>(sm);
        const float mean = sm * (1.f / 64.f);
        float sq = 0.f;
#pragma unroll
        for (int j = 0; j < 8; ++j) { y[j] -= mean; sq += y[j] * y[j]; }
        sq += dppf0<0xB1>(sq); sq += dppf0<0x4E>(sq); sq += dppf0<0x141>(sq);
        const float rstd = rsqrtf(sq * (1.f / 64.f) + 64e-5f);
        const unsigned zcw[4] = {zc4[r].x, zc4[r].y, zc4[r].z, zc4[r].w}, zpw[4] = {zp4[r].x, zp4[r].y, zp4[r].z, zp4[r].w};
        const unsigned znw[4] = {zn4[r].x, zn4[r].y, zn4[r].z, zn4[r].w}, gw[4] = {g4[r].x, g4[r].y, g4[r].z, g4[r].w};
        float o[8];
#pragma unroll
        for (int j = 0; j < 4; ++j) {
#pragma unroll
          for (int e = 0; e < 2; ++e) {
            const int jj = 2 * j + e;
            const float zc = e ? __uint_as_float(zcw[j] & 0xffff0000u) : __uint_as_float(zcw[j] << 16);
            const float zp = e ? __uint_as_float(zpw[j] & 0xffff0000u) : __uint_as_float(zpw[j] << 16);
            const float zn = e ? __uint_as_float(znw[j] & 0xffff0000u) : __uint_as_float(znw[j] << 16);
            const float g = e ? __uint_as_float(gw[j] & 0xffff0000u) : __uint_as_float(gw[j] << 16);
            const float vs = zc + muv[jj] * (0.5f * (zp + zn) - zc);
            const float yn = y[jj] * rstd * gng[jj] + gnb[jj];
            o[jj] = (yn + bet[r] * vs) * siluf_(g);
          }
        }
        *(uint4*)(p.ycat + (size_t)tok * DM + 512 + ch0) = make_uint4(pk_bf16(o[0], o[1]), pk_bf16(o[2], o[3]), pk_bf16(o[4], o[5]), pk_bf16(o[6], o[7]));
      }
    }
  }
}

template <bool XBF>
__device__ __forceinline__ void phase_ln(const void* xin_, const bf16_t* hb, float* yout, const float* __restrict__ g, const float* __restrict__ bb, bf16_t* ob) {
  const float* xin = (const float*)xin_; const bf16_t* xinb = (const bf16_t*)xin_;
  const int lane = threadIdx.x & 63, wid = threadIdx.x >> 6;
  const int stride = gridDim.x * 8;
  f32x4 gg[4], b4[4];
#pragma unroll
  for (int i = 0; i < 2; ++i) { const int c = lane * 8 + 512 * i; gg[2 * i] = *(const f32x4*)(g + c); gg[2 * i + 1] = *(const f32x4*)(g + c + 4); b4[2 * i] = *(const f32x4*)(bb + c); b4[2 * i + 1] = *(const f32x4*)(bb + c + 4); }
  for (int row0 = blockIdx.x * 8 + wid; row0 < NTOK; row0 += 2 * stride) {
    f32x4 xv[2][4]; uint4 hv[2][2];
#pragma unroll
    for (int r = 0; r < 2; ++r) {
      const int row = row0 + r * stride;
      if (row < NTOK) {
#pragma unroll
        for (int i = 0; i < 2; ++i) {
          const int c = lane * 8 + 512 * i;
          if (XBF) {
            const uint4 xq = *(const uint4*)(xinb + (size_t)row * DM + c);
            xv[r][2 * i] = (f32x4){__uint_as_float(xq.x << 16), __uint_as_float(xq.x & 0xffff0000u), __uint_as_float(xq.y << 16), __uint_as_float(xq.y & 0xffff0000u)};
            xv[r][2 * i + 1] = (f32x4){__uint_as_float(xq.z << 16), __uint_as_float(xq.z & 0xffff0000u), __uint_as_float(xq.w << 16), __uint_as_float(xq.w & 0xffff0000u)};
          } else {
            xv[r][2 * i] = *(const f32x4*)(xin + (size_t)row * DM + c); xv[r][2 * i + 1] = *(const f32x4*)(xin + (size_t)row * DM + c + 4);
          }
          hv[r][i] = *(const uint4*)(hb + (size_t)row * DM + c);
        }
      }
    }
#pragma unroll
    for (int r = 0; r < 2; ++r) {
      const int row = row0 + r * stride;
      if (row < NTOK) {
        float v[16]; float s = 0.f;
#pragma unroll
        for (int i = 0; i < 2; ++i) {
          const unsigned hw[4] = {hv[r][i].x, hv[r][i].y, hv[r][i].z, hv[r][i].w};
#pragma unroll
          for (int j = 0; j < 4; ++j) {
            const float xa = (j < 2) ? xv[r][2 * i][2 * j] : xv[r][2 * i + 1][2 * j - 4], xb2 = (j < 2) ? xv[r][2 * i][2 * j + 1] : xv[r][2 * i + 1][2 * j - 3];
            v[8 * i + 2 * j] = ALPHA * xa + __uint_as_float(hw[j] << 16);
            v[8 * i + 2 * j + 1] = ALPHA * xb2 + __uint_as_float(hw[j] & 0xffff0000u);
            s += v[8 * i + 2 * j] + v[8 * i + 2 * j + 1];
          }
        }
        const float mean = wave_sum(s) * (1.f / 1024.f);
        float q = 0.f;
#pragma unroll
        for (int i = 0; i < 16; ++i) { v[i] -= mean; q += v[i] * v[i]; }
        const float rstd = rsqrtf(wave_sum(q) * (1.f / 1024.f) + 1e-5f);
#pragma unroll
        for (int i = 0; i < 2; ++i) {
          const int c = lane * 8 + 512 * i;
          f32x4 o0, o1;
#pragma unroll
          for (int j = 0; j < 4; ++j) { o0[j] = v[8 * i + j] * rstd * gg[2 * i][j] + b4[2 * i][j]; o1[j] = v[8 * i + 4 + j] * rstd * gg[2 * i + 1][j] + b4[2 * i + 1][j]; }
          if (yout) { *(f32x4*)(yout + (size_t)row * DM + c) = o0; *(f32x4*)(yout + (size_t)row * DM + c + 4) = o1; }
          if (ob) *(uint4*)(ob + (size_t)row * DM + c) = make_uint4(pk_bf16(o0[0], o0[1]), pk_bf16(o0[2], o0[3]), pk_bf16(o1[0], o1[1]), pk_bf16(o1[2], o1[3]));
        }
      }
    }
  }
}


__device__ __forceinline__ void phase_lr(const Params& p, char* smem) {
  bf16_t* WL = (bf16_t*)smem;
  const int tid = threadIdx.x, lane = tid & 63, wid = tid >> 6, fr = lane & 15, fq = lane >> 4;
#pragma unroll
  for (int i = 0; i < 8; ++i) {
    const int q = tid + 512 * i; const int n = q >> 7, ck = q & 127;
    *(uint4*)(WL + n * 1032 + ck * 8) = *(const uint4*)(p.wt1 + (size_t)(3072 + n) * DM + ck * 8);
  }
  __syncthreads();
  for (int tile = blockIdx.x * 8 + wid; tile < NTOK / 16; tile += gridDim.x * 8) {
    const bf16_t* ap = p.x1k + (size_t)(tile * 16 + fr) * DM + fq * 8;
    const bf16_t* w0p = WL + fr * 1032 + fq * 8;
    const bf16_t* w1p = WL + (16 + fr) * 1032 + fq * 8;
    f32x4 acc0 = (f32x4){0.f, 0.f, 0.f, 0.f}, acc1 = (f32x4){0.f, 0.f, 0.f, 0.f};
#pragma unroll 16
    for (int ks = 0; ks < 32; ++ks) {
      const bf16x8 a = *(const bf16x8*)(ap + ks * 32);
      const bf16x8 w0 = *(const bf16x8*)(w0p + ks * 32), w1 = *(const bf16x8*)(w1p + ks * 32);
      acc0 = __builtin_amdgcn_mfma_f32_16x16x32_bf16(w0, a, acc0, 0, 0, 0);
      acc1 = __builtin_amdgcn_mfma_f32_16x16x32_bf16(w1, a, acc1, 0, 0, 0);
    }
    bf16_t* op = p.lrb + (size_t)(tile * 16 + fr) * 32 + fq * 4;
    *(uint2*)op = make_uint2(pk_bf16(acc0[0], acc0[1]), pk_bf16(acc0[2], acc0[3]));
    *(uint2*)(op + 16) = make_uint2(pk_bf16(acc1[0], acc1[1]), pk_bf16(acc1[2], acc1[3]));
  }
  __syncthreads();
}

__device__ __forceinline__ int swz64(int row, int ch) { return row * 64 + ((ch ^ ((row >> 1) & 7)) << 3); }

__device__ __forceinline__ void phase_gla(const Params& p, char* smem) {
  bf16_t* QT = (bf16_t*)smem;
  bf16_t* KT = QT + 64 * 136;
  bf16_t* KRT = KT + 64 * 136;
  bf16_t* VT = KRT + 128 * 72;
  bf16_t* PP = VT + 128 * 72;
  bf16_t* ST = PP + 64 * 72;
  float* LR = (float*)(ST + 128 * 136);
  float* GT = LR + 1024;
  float* DEC = GT + 1024;
  float* LR1 = DEC + 128;
  const int tid = threadIdx.x, lane = tid & 63, wid = tid >> 6;
  const int fr = lane & 15, fq = lane >> 4;
  const int c2 = tid & 63, tg = tid >> 6;
  for (int item = blockIdx.x; item < 256; item += gridDim.x) {
    const int d = item >> 7, b = (item >> 3) & 15, h = (item >> 1) & 3, vh = item & 1;
    __syncthreads();
    for (int i = tid; i < 128 * 136 / 2; i += NTHR) ((unsigned*)ST)[i] = 0u;
    f32x2 gup2[16];
#pragma unroll
    for (int r = 0; r < 16; ++r) gup2[r] = *(const f32x2*)(p.g_up + ((size_t)d * 16 + r) * 512 + h * 128 + 2 * c2);
    const f32x2 gb2 = *(const f32x2*)(p.g_bias + d * 512 + h * 128 + 2 * c2);
    f32x4 accs[8];
#pragma unroll
    for (int i = 0; i < 8; ++i) accs[i] = (f32x4){0.f, 0.f, 0.f, 0.f};
    const bf16_t* pbase = p.proj + (size_t)b * T_ * N1P;
    bf16_t lrr[2]; unsigned qr[8], kr[8], vr[8];
#define GLA_LOAD_RAW(CI) do { \
      _Pragma("unroll") for (int i2_ = 0; i2_ < 2; ++i2_) { \
        const int e_ = tid + 512 * i2_; const int tok_ = e_ >> 4, r_ = e_ & 15; \
        const int s_ = (CI) * 64 + tok_; const int t_ = d ? (T_ - 1 - s_) : s_; \
        lrr[i2_] = p.lrb[((size_t)b * T_ + t_) * 32 + d * 16 + r_]; } \
      _Pragma("unroll") for (int ii_ = 0; ii_ < 8; ++ii_) { \
        const int s_ = (CI) * 64 + tg * 8 + ii_; const int t_ = d ? (T_ - 1 - s_) : s_; \
        const bf16_t* rowp_ = pbase + (size_t)t_ * N1P; \
        qr[ii_] = *(const unsigned*)(rowp_ + h * 128 + 2 * c2); kr[ii_] = *(const unsigned*)(rowp_ + 512 + h * 128 + 2 * c2); \
        vr[ii_] = *(const unsigned*)(rowp_ + 1024 + h * 256 + vh * 128 + 2 * c2); } } while (0)
    GLA_LOAD_RAW(0);
    for (int ci = 0; ci < 32; ++ci) {
#pragma unroll
      for (int i2 = 0; i2 < 2; ++i2) { const int e = tid + 512 * i2; LR[(e >> 4) * 16 + (e & 15)] = bf2f(lrr[i2]); }
      __syncthreads();
      f32x2 bl[8]; f32x2 cum = (f32x2){0.f, 0.f};
#pragma unroll
      for (int ii = 0; ii < 8; ++ii) {
        const int i = tg * 8 + ii;
        f32x2 xg = gb2;
#pragma unroll
        for (int r4 = 0; r4 < 4; ++r4) {
          const f32x4 l4 = *(const f32x4*)(LR + i * 16 + r4 * 4);
          xg += (f32x2){l4[0], l4[0]} * gup2[r4 * 4 + 0];
          xg += (f32x2){l4[1], l4[1]} * gup2[r4 * 4 + 1];
          xg += (f32x2){l4[2], l4[2]} * gup2[r4 * 4 + 2];
          xg += (f32x2){l4[3], l4[3]} * gup2[r4 * 4 + 3];
        }
        f32x2 ls;
        ls[0] = fminf(xg[0], 0.f) - 0.69314718056f * __builtin_amdgcn_logf(1.f + __expf(-fabsf(xg[0])));
        ls[1] = fminf(xg[1], 0.f) - 0.69314718056f * __builtin_amdgcn_logf(1.f + __expf(-fabsf(xg[1])));
        cum += ls * (1.f / 16.f);
        bl[ii] = cum;
      }
      *(f32x2*)(GT + (tg * 64 + c2) * 2) = cum;
      __syncthreads();
      {
        f32x2 offs = (f32x2){0.f, 0.f}, total = (f32x2){0.f, 0.f};
#pragma unroll
        for (int g2 = 0; g2 < 8; ++g2) { const f32x2 gv = *(const f32x2*)(GT + (g2 * 64 + c2) * 2); total += gv; if (g2 < tg) offs += gv; }
        f32x2 krv[8];
        f32x2 etot; etot[0] = __expf(total[0]); etot[1] = __expf(total[1]);
#pragma unroll
        for (int ii = 0; ii < 8; ++ii) {
          const int i = tg * 8 + ii;
          const f32x2 bv = bl[ii] + offs;
          f32x2 eb, ebi;
          eb[0] = __expf(bv[0]); eb[1] = __expf(bv[1]);
          ebi[0] = __builtin_amdgcn_rcpf(eb[0]); ebi[1] = __builtin_amdgcn_rcpf(eb[1]);
          const f32x2 qraw = (f32x2){__uint_as_float(qr[ii] << 16), __uint_as_float(qr[ii] & 0xffff0000u)};
          const f32x2 kraw = (f32x2){__uint_as_float(kr[ii] << 16), __uint_as_float(kr[ii] & 0xffff0000u)};
          const f32x2 qv = qraw * 0.08838834764831845f * eb;
          const f32x2 kv = kraw * ebi;
          *(unsigned*)(QT + i * 136 + 2 * c2) = pk_bf16(qv[0], qv[1]);
          *(unsigned*)(KT + i * 136 + 2 * c2) = pk_bf16(kv[0], kv[1]);
          krv[ii] = kv * etot;
        }
        *(uint4*)(KRT + swz64(2 * c2, tg)) = make_uint4(pk_bf16(krv[0][0], krv[1][0]), pk_bf16(krv[2][0], krv[3][0]), pk_bf16(krv[4][0], krv[5][0]), pk_bf16(krv[6][0], krv[7][0]));
        *(uint4*)(KRT + swz64(2 * c2 + 1, tg)) = make_uint4(pk_bf16(krv[0][1], krv[1][1]), pk_bf16(krv[2][1], krv[3][1]), pk_bf16(krv[4][1], krv[5][1]), pk_bf16(krv[6][1], krv[7][1]));
        *(uint4*)(VT + swz64(2 * c2, tg)) = make_uint4((vr[0] & 0xffffu) | (vr[1] << 16), (vr[2] & 0xffffu) | (vr[3] << 16), (vr[4] & 0xffffu) | (vr[5] << 16), (vr[6] & 0xffffu) | (vr[7] << 16));
        *(uint4*)(VT + swz64(2 * c2 + 1, tg)) = make_uint4((vr[0] >> 16) | (vr[1] & 0xffff0000u), (vr[2] >> 16) | (vr[3] & 0xffff0000u), (vr[4] >> 16) | (vr[5] & 0xffff0000u), (vr[6] >> 16) | (vr[7] & 0xffff0000u));
        if (tg == 0) *(f32x2*)(DEC + 2 * c2) = etot;
      }
      if (ci + 1 < 32) GLA_LOAD_RAW(ci + 1);
      __syncthreads();
#pragma unroll
      for (int tt = 0; tt < 2; ++tt) {
        const int tile = wid * 2 + tt; const int it = tile >> 2, jt = tile & 3;
        f32x4 acc = (f32x4){0.f, 0.f, 0.f, 0.f};
#pragma unroll
        for (int ks = 0; ks < 4; ++ks) {
          const bf16x8 a_op = *(const bf16x8*)(KT + (jt * 16 + fr) * 136 + ks * 32 + fq * 8);
          const bf16x8 b_op = *(const bf16x8*)(QT + (it * 16 + fr) * 136 + ks * 32 + fq * 8);
          acc = __builtin_amdgcn_mfma_f32_16x16x32_bf16(a_op, b_op, acc, 0, 0, 0);
        }
        const int i = it * 16 + fr, j0 = jt * 16 + fq * 4;
        const float p0 = (j0 + 0 <= i) ? acc[0] : 0.f, p1 = (j0 + 1 <= i) ? acc[1] : 0.f;
        const float p2 = (j0 + 2 <= i) ? acc[2] : 0.f, p3 = (j0 + 3 <= i) ? acc[3] : 0.f;
        uint2 o; o.x = pk_bf16(p0, p1); o.y = pk_bf16(p2, p3);
        *(uint2*)(PP + swz64(i, j0 >> 3) + (j0 & 7)) = o;
      }
      __syncthreads();
      {
        f32x4 acco[4];
#pragma unroll
        for (int mi = 0; mi < 4; ++mi) acco[mi] = (f32x4){0.f, 0.f, 0.f, 0.f};
#pragma unroll
        for (int ks = 0; ks < 2; ++ks) {
          const bf16x8 a_op = *(const bf16x8*)(VT + swz64(wid * 16 + fr, ks * 4 + fq));
#pragma unroll
          for (int mi = 0; mi < 4; ++mi) {
            const bf16x8 b_op = *(const bf16x8*)(PP + swz64(mi * 16 + fr, ks * 4 + fq));
            acco[mi] = __builtin_amdgcn_mfma_f32_16x16x32_bf16(a_op, b_op, acco[mi], 0, 0, 0);
          }
        }
#pragma unroll
        for (int ks = 0; ks < 4; ++ks) {
          const bf16x8 a_op = *(const bf16x8*)(ST + (wid * 16 + fr) * 136 + ks * 32 + fq * 8);
#pragma unroll
          for (int mi = 0; mi < 4; ++mi) {
            const bf16x8 b_op = *(const bf16x8*)(QT + (mi * 16 + fr) * 136 + ks * 32 + fq * 8);
            acco[mi] = __builtin_amdgcn_mfma_f32_16x16x32_bf16(a_op, b_op, acco[mi], 0, 0, 0);
          }
        }
#pragma unroll
        for (int mi = 0; mi < 4; ++mi) {
          const int i = mi * 16 + fr;
          const int s = ci * 64 + i; const int t = d ? (T_ - 1 - s) : s;
          uint2 o; o.x = pk_bf16(acco[mi][0], acco[mi][1]); o.y = pk_bf16(acco[mi][2], acco[mi][3]);
          *(uint2*)(p.go + ((size_t)d * NTOK + (size_t)b * T_ + t) * DM + h * 256 + vh * 128 + wid * 16 + fq * 4) = o;
        }
      }
      bf16x8 vfr[2];
#pragma unroll
      for (int ks = 0; ks < 2; ++ks) vfr[ks] = *(const bf16x8*)(VT + swz64(wid * 16 + fr, ks * 4 + fq));
#pragma unroll
      for (int ct = 0; ct < 8; ++ct) {
        const f32x4 dec = *(const f32x4*)(DEC + ct * 16 + fq * 4);
        accs[ct] = accs[ct] * dec;
#pragma unroll
        for (int ks = 0; ks < 2; ++ks) {
          const bf16x8 a_op = *(const bf16x8*)(KRT + swz64(ct * 16 + fr, ks * 4 + fq));
          accs[ct] = __builtin_amdgcn_mfma_f32_16x16x32_bf16(a_op, vfr[ks], accs[ct], 0, 0, 0);
        }
        uint2 o; o.x = pk_bf16(accs[ct][0], accs[ct][1]); o.y = pk_bf16(accs[ct][2], accs[ct][3]);
        *(uint2*)(ST + (wid * 16 + fr) * 136 + ct * 16 + fq * 4) = o;
      }
      __syncthreads();
    }
  }
}

__device__ __forceinline__ void phase_gla_fin(const Params& p) {
  const int lane = threadIdx.x & 63, wid = threadIdx.x >> 6;
  const int n0 = lane * 16;
  float ng[16];
#pragma unroll
  for (int j = 0; j < 16; ++j) ng[j] = p.norm_g[n0 + j];
  const int stride = gridDim.x * 8;
  for (int tok0 = blockIdx.x * 8 + wid; tok0 < NTOK; tok0 += 2 * stride) {
    uint4 av[2][2], bv[2][2], gv[2][2];
#pragma unroll
    for (int r = 0; r < 2; ++r) {
      const int tok = tok0 + r * stride;
      if (tok < NTOK) {
        av[r][0] = *(const uint4*)(p.go + (size_t)tok * DM + n0); av[r][1] = *(const uint4*)(p.go + (size_t)tok * DM + n0 + 8);
        bv[r][0] = *(const uint4*)(p.go + ((size_t)NTOK + tok) * DM + n0); bv[r][1] = *(const uint4*)(p.go + ((size_t)NTOK + tok) * DM + n0 + 8);
        gv[r][0] = *(const uint4*)(p.proj + (size_t)tok * N1P + 2048 + n0); gv[r][1] = *(const uint4*)(p.proj + (size_t)tok * N1P + 2048 + n0 + 8);
      }
    }
#pragma unroll
    for (int r = 0; r < 2; ++r) {
      const int tok = tok0 + r * stride;
      if (tok < NTOK) {
        const unsigned aw[8] = {av[r][0].x, av[r][0].y, av[r][0].z, av[r][0].w, av[r][1].x, av[r][1].y, av[r][1].z, av[r][1].w};
        const unsigned bw[8] = {bv[r][0].x, bv[r][0].y, bv[r][0].z, bv[r][0].w, bv[r][1].x, bv[r][1].y, bv[r][1].z, bv[r][1].w};
        const unsigned gw[8] = {gv[r][0].x, gv[r][0].y, gv[r][0].z, gv[r][0].w, gv[r][1].x, gv[r][1].y, gv[r][1].z, gv[r][1].w};
        float o[16]; float sq = 0.f;
#pragma unroll
        for (int j = 0; j < 8; ++j) {
          o[2 * j] = __uint_as_float(aw[j] << 16) + __uint_as_float(bw[j] << 16);
          o[2 * j + 1] = __uint_as_float(aw[j] & 0xffff0000u) + __uint_as_float(bw[j] & 0xffff0000u);
          sq += o[2 * j] * o[2 * j] + o[2 * j + 1] * o[2 * j + 1];
        }
        sq += dppf0<0xB1>(sq); sq += dppf0<0x4E>(sq); sq += dppf0<0x141>(sq); sq += dppf0<0x140>(sq);
        const float rs = rsqrtf(sq * (1.f / 256.f) + 1e-6f);
        unsigned ow[8];
#pragma unroll
        for (int j = 0; j < 8; ++j) {
          const float ga = __uint_as_float(gw[j] << 16), gb2 = __uint_as_float(gw[j] & 0xffff0000u);
          ow[j] = pk_bf16(o[2 * j] * rs * ng[2 * j] * siluf_(ga), o[2 * j + 1] * rs * ng[2 * j + 1] * siluf_(gb2));
        }
        *(uint4*)(p.ycat + (size_t)tok * DM + n0) = make_uint4(ow[0], ow[1], ow[2], ow[3]);
        *(uint4*)(p.ycat + (size_t)tok * DM + n0 + 8) = make_uint4(ow[4], ow[5], ow[6], ow[7]);
      }
    }
  }
}

__device__ __forceinline__ void phase_dump(const Params& p, int mode) {
  for (size_t i = (size_t)blockIdx.x * NTHR + threadIdx.x; i < (size_t)NTOK * DM; i += (size_t)gridDim.x * NTHR) {
    const size_t tok = i >> 10; const int n = (int)(i & 1023);
    float v = 0.f;
    if (mode == 1) {
      v = bf2f(p.proj[tok * N0P + n]) + bf2f(p.proj[tok * N0P + 1024 + n]) + bf2f(p.proj[tok * N0P + 2048 + n]);
      if (n < 768) v += bf2f(p.proj[tok * N0P + 3072 + n]);
    } else if (mode == 2) {
      if (n < 512) v = bf2f(p.ycat[tok * DM + n]);
      else v = bf2f(p.ys[tok * 512 + (n - 512)]) + bf2f(p.ys[((size_t)NTOK + tok) * 512 + (n - 512)]) + ((n < 520) ? p.beta[tok * 8 + (n - 512)] + p.beta[((size_t)NTOK + tok) * 8 + (n - 512)] : 0.f);
    } else if (mode == 3) {
      v = bf2f(p.ycat[tok * DM + n]);
    } else if (mode == 4) {
      v = bf2f(p.xb[i]) + bf2f(p.wt0[i % ((size_t)N0P * DM)]) + bf2f(p.wt1[i % ((size_t)N1W * DM)]) + bf2f(p.wto0[i % ((size_t)DM * DM)]) + bf2f(p.wto1[i % ((size_t)DM * DM)]);
    }
    p.out[i] = v;
  }
}

#define XB_TMO      128
#define XB_XCNT(j)  (256  + 64 * (j))
#define XB_XSUB(j)  (1280 + 64 * (j))
#define XB_XGEN(j)  (2304 + 64 * (j))
#define XB_TOP      3328
#define XB_TOPGEN   3392
#define XCD_BAR_WORDS 3456
#define XB_SPIN_CAP (1u << 18)
#define XB_LAS __attribute__((address_space(3)))
__device__ __forceinline__ unsigned xb_ld(unsigned* p)              { return __hip_atomic_load(p, __ATOMIC_RELAXED, __HIP_MEMORY_SCOPE_AGENT); }
__device__ __forceinline__ unsigned xb_add(unsigned* p, unsigned v) { return __hip_atomic_fetch_add(p, v, __ATOMIC_RELAXED, __HIP_MEMORY_SCOPE_AGENT); }
__device__ __forceinline__ unsigned xb_xcc_id() { return (unsigned)__builtin_amdgcn_s_getreg((3 << 11) | 20) & 0xFu; }
#define XB_SPIN(cond, bar) do { unsigned _sp = 0; while (cond) { __builtin_amdgcn_s_sleep(1); \
    if ((++_sp & 255u) == 0u) { if (xb_ld(&(bar)[XB_TMO])) break; if (_sp > XB_SPIN_CAP) { atomicAdd(&(bar)[XB_TMO], 1u); break; } } } } while (0)
struct XcdBarrier { unsigned* bar; unsigned x; volatile XB_LAS unsigned* st; };
__device__ __forceinline__ XcdBarrier xcd_barrier_post(unsigned* bar, volatile XB_LAS unsigned* st) {
  XcdBarrier b; b.bar = bar; b.x = xb_xcc_id(); b.st = st;
  if (threadIdx.x == 0) (void)xb_add(&bar[XB_XCNT(b.x)], 1u);
  return b;
}
__device__ __forceinline__ void xcd_barrier_complete(unsigned* bar, unsigned x, unsigned& nloc, unsigned& nx) {
  const unsigned G = gridDim.x * gridDim.y * gridDim.z;
  unsigned sum, cnt, mine, sp = 0u;
  for (;;) {
    sum = 0u; cnt = 0u; mine = 0u;
#pragma unroll
    for (unsigned j = 0; j < 16; ++j) { const unsigned c = xb_ld(&bar[XB_XCNT(j)]); sum += c; cnt += (c > 0u) ? 1u : 0u; mine = (j == x) ? c : mine; }
    if (sum == G) break;
    __builtin_amdgcn_s_sleep(1);
    if ((++sp & 255u) == 0u) { if (xb_ld(&bar[XB_TMO])) break; if (sp > XB_SPIN_CAP) { atomicAdd(&bar[XB_TMO], 1u); break; } }
  }
  nloc = mine > 0u ? mine : 1u; nx = cnt > 0u ? cnt : 1u;
}
__device__ __forceinline__ void xcd_barrier(const XcdBarrier& b) {
  asm volatile("s_waitcnt vmcnt(0)" ::: "memory");
  __syncthreads();
  if (threadIdx.x == 0) {
    unsigned* bar = b.bar;
    __builtin_amdgcn_s_waitcnt(0);
    unsigned nloc = b.st[0], nx = b.st[1];
    if (nloc == 0u) { xcd_barrier_complete(bar, b.x, nloc, nx); b.st[0] = nloc; b.st[1] = nx; }
    const unsigned old = xb_add(&bar[XB_XSUB(b.x)], 1u);
    const unsigned gen = old / nloc;
    if (old + 1u == (gen + 1u) * nloc) {
      __builtin_amdgcn_fence(__ATOMIC_RELEASE, "agent");
      asm volatile("s_waitcnt vmcnt(0)" ::: "memory");
      const unsigned og = xb_add(&bar[XB_TOP], 1u);
      const unsigned tg = og / nx;
      if (og + 1u == (tg + 1u) * nx) xb_add(&bar[XB_TOPGEN], 1u);
      else XB_SPIN(xb_ld(&bar[XB_TOPGEN]) == tg, bar);
      __builtin_amdgcn_fence(__ATOMIC_ACQUIRE, "agent");
      xb_add(&bar[XB_XGEN(b.x)], 1u);
      asm volatile("s_waitcnt vmcnt(0)" ::: "memory");
    } else {
      XB_SPIN(xb_ld(&bar[XB_XGEN(b.x)]) == gen, bar);
      __builtin_amdgcn_fence(__ATOMIC_ACQUIRE, "agent");
      asm volatile("s_waitcnt vmcnt(0)" ::: "memory");
    }
  }
  __syncthreads();
}

__global__ void __launch_bounds__(NTHR) mega(Params p) {
  __shared__ __attribute__((aligned(16))) char smem[LDS_BYTES];
  cg::grid_group grid = cg::this_grid();
  if (threadIdx.x == 0) *(uint4*)(smem + LDS_BYTES - 16) = make_uint4(0u, 0u, 0u, 0u);
  __syncthreads();
  const XcdBarrier xb = xcd_barrier_post(p.bar, (volatile XB_LAS unsigned*)(smem + LDS_BYTES - 16));
  if (p.ph_hi > 1000) grid.sync();
#define RUN_PHASE(PH, CALL) \
  if (p.ph_lo <= (PH) && (PH) <= p.ph_hi) { CALL; } \
  if (p.ph_lo <= (PH) && (PH) < p.ph_hi) xcd_barrier(xb);
  RUN_PHASE(0, phase_prep(p, smem))
  RUN_PHASE(1, gemm_run(p.xb, p.wt0, N0P, pg8::EpiBf16{p.proj, N0P}, smem); phase_prep_late(p, smem))
  RUN_PHASE(2, phase_conv(p, smem); phase_scan(p, smem))
  RUN_PHASE(3, phase_rwkv_fin(p))
  RUN_PHASE(4, gemm_run(p.ycat, p.wto0, DM, pg8::EpiBf16{p.hb, DM}, smem))
  RUN_PHASE(5, phase_ln<true>(p.xb, p.hb, nullptr, p.ln0_g, p.ln0_b, p.x1k))
  RUN_PHASE(6, gemm_run(p.x1k, p.wt1, N1P, pg8::EpiBf16{p.proj, N1P}, smem); phase_lr(p, smem))
  RUN_PHASE(7, phase_gla(p, smem))
  RUN_PHASE(8, phase_gla_fin(p))
  RUN_PHASE(9, gemm_run(p.ycat, p.wto1, DM, pg8::EpiBf16{p.hb, DM}, smem))
  RUN_PHASE(10, phase_ln<true>(p.x1k, p.hb, p.out, p.ln1_g, p.ln1_b, nullptr))
  RUN_PHASE(11, phase_dump(p, DUMPMODE))
}

extern "C" void kernel_launch(void* const* d_in, const int* in_sizes, int n_in, void* d_out, int out_size,
                              void* d_ws, size_t ws_size, hipStream_t stream) {
  Params p{};
  p.x = (const float*)d_in[0]; p.w_in0 = (const float*)d_in[1]; p.conv_w = (const float*)d_in[2]; p.conv_b = (const float*)d_in[3];
  p.conv_ln_g = (const float*)d_in[4]; p.conv_ln_b = (const float*)d_in[5]; p.mu = (const float*)d_in[6]; p.w0 = (const float*)d_in[7];
  p.w_up = (const float*)d_in[8]; p.a0 = (const float*)d_in[9]; p.a_up = (const float*)d_in[10]; p.k_k = (const float*)d_in[11];
  p.k_a = (const float*)d_in[12]; p.r_k = (const float*)d_in[13]; p.gn_g = (const float*)d_in[14]; p.gn_b = (const float*)d_in[15];
  p.w_out0 = (const float*)d_in[16]; p.ln0_g = (const float*)d_in[17]; p.ln0_b = (const float*)d_in[18];
  p.w_in1 = (const float*)d_in[19]; p.g_up = (const float*)d_in[20]; p.g_bias = (const float*)d_in[21]; p.norm_g = (const float*)d_in[22];
  p.w_out1 = (const float*)d_in[23]; p.ln1_g = (const float*)d_in[24]; p.ln1_b = (const float*)d_in[25];
  p.out = (float*)d_out;
  char* ws = (char*)d_ws;
  size_t off = 0;
  p.xb = (bf16_t*)(ws + off); p.ys = (bf16_t*)(ws + off + ((size_t)64 << 20)); p.go = (bf16_t*)(ws + off); p.hb = (bf16_t*)(ws + off + ((size_t)64 << 20)); off += (size_t)128 << 20;
  p.wt0 = (bf16_t*)(ws + off); off += (size_t)N0P * DM * 2;
  p.wto0 = (bf16_t*)(ws + off); off += (size_t)DM * DM * 2;
  p.wt1 = (bf16_t*)(ws + off); off += (size_t)N1W * DM * 2;
  p.wto1 = (bf16_t*)(ws + off); off += (size_t)DM * DM * 2;
  p.ycat = (bf16_t*)(ws + off); off += (size_t)NTOK * DM * 2;
  p.beta = (float*)(ws + off); off += (size_t)2 * NB_ * T_ * 8 * 4;
  p.proj = (bf16_t*)(ws + off);
  p.x1k = (bf16_t*)(ws + off + (size_t)NTOK * N1P * 2);
  p.bar = (unsigned*)(ws + ((size_t)496 << 20));
  p.lrb = (bf16_t*)(ws + ((size_t)498 << 20));
  p.ph_lo = 0; p.ph_hi = 10;
  static int grid_blocks = 0;
  if (!grid_blocks) {
    int dev = 0, cus = 0, per_cu = 0;
    hipGetDevice(&dev);
    hipDeviceGetAttribute(&cus, hipDeviceAttributeMultiprocessorCount, dev);
    hipOccupancyMaxActiveBlocksPerMultiprocessor(&per_cu, mega, NTHR, 0);
    if (per_cu < 1) per_cu = 1;
    if (per_cu > 1) per_cu = 1;
    grid_blocks = cus * per_cu;
  }
#ifdef MULTI_LAUNCH
  for (int ph = 0; ph <= MAXPH; ++ph) {
    p.ph_lo = ph; p.ph_hi = ph;
    hipLaunchKernelGGL(mega, dim3(grid_blocks), dim3(NTHR), 0, stream, p);
  }
  p.ph_lo = 11; p.ph_hi = 11;
  hipLaunchKernelGGL(mega, dim3(grid_blocks), dim3(NTHR), 0, stream, p);
#else
  (void)hipMemsetAsync(p.bar, 0, XCD_BAR_WORDS * sizeof(unsigned), stream);
  void* args[] = {&p};
  hipError_t e = hipLaunchCooperativeKernel((void*)mega, dim3(grid_blocks), dim3(NTHR), args, 0, stream);
  if (e != hipSuccess) fprintf(stderr, "cooperative launch failed: %s (grid %d)\n", hipGetErrorString(e), grid_blocks);
#endif
}
```
